# Optimizing an MI355X kernel written in HIP

```python
import math
import jax
import jax.numpy as jnp
from jax import lax
import numpy as np

D_MODEL = 2048
BATCH = 8
SEQ = 2048
DEPTH = 2

PLE_DIM = 256
NORM_EPS = 1e-6
ROPE_THETA = 10000.0
NEG_INF = -1e30
FORCE_SCORE = 1e4
Q_BLOCK = 128

N_BRANCH = 4
MIX_WIDTH = D_MODEL // 2

SSD_D_INNER = MIX_WIDTH
SSD_HEAD_DIM = 64
SSD_N_HEADS = SSD_D_INNER // SSD_HEAD_DIM
SSD_N_GROUPS = 2
SSD_HPG = SSD_N_HEADS // SSD_N_GROUPS
SSD_D_STATE = 128
SSD_CONV = 4
SSD_CHUNK = 128
SSD_CONV_DIM = SSD_D_INNER + 2 * SSD_N_GROUPS * SSD_D_STATE

DIFF_N_HEADS = 8
DIFF_HEAD_DIM = 64
DIFF_V_DIM = 2 * DIFF_HEAD_DIM
DIFF_WIDTH = DIFF_N_HEADS * DIFF_V_DIM

NSA_N_HEADS = 16
NSA_N_KV = 4
NSA_HPG = NSA_N_HEADS // NSA_N_KV
NSA_HEAD_DIM = 64
NSA_WIDTH = NSA_N_HEADS * NSA_HEAD_DIM
NSA_KV_WIDTH = NSA_N_KV * NSA_HEAD_DIM
CMP_BLOCK = 32
CMP_STRIDE = 16
CMP_HIDDEN = 256
SEL_BLOCK = 64
SEL_TOPK = 8
WINDOW = 512

RNN_WIDTH = MIX_WIDTH
RNN_BLOCKS = 16
RNN_BLOCK_DIM = RNN_WIDTH // RNN_BLOCKS
RNN_CONV = 4
RG_C = 8.0

D_FF = 3 * D_MODEL
FFN_CONV = 3

IN_WIDTHS = (
    SSD_D_INNER, SSD_CONV_DIM, SSD_N_HEADS,
    DIFF_WIDTH, DIFF_WIDTH, DIFF_WIDTH,
    NSA_WIDTH, NSA_KV_WIDTH, NSA_KV_WIDTH, NSA_KV_WIDTH,
    NSA_KV_WIDTH, NSA_KV_WIDTH, NSA_KV_WIDTH, NSA_N_HEADS * 3,
    RNN_WIDTH, RNN_WIDTH,
)
D_IN = sum(IN_WIDTHS)
IN_OFFSETS = tuple(sum(IN_WIDTHS[:i + 1]) for i in range(len(IN_WIDTHS) - 1))

kernel_name = 'hybrid_ssd_diffattn_nsa_rglru_block'


def rmsnorm(x, g):
    xf = x.astype(jnp.float32)
    y = xf * lax.rsqrt(jnp.mean(xf * xf, axis=-1, keepdims=True) + NORM_EPS)
    return (y * g.astype(jnp.float32)).astype(x.dtype)


def causal_dwconv(x, w, b):
    k_width = w.shape[0]
    s = x.shape[1]
    xp = jnp.pad(x, ((0, 0), (k_width - 1, 0), (0, 0)))
    y = b
    for k in range(k_width):
        y = y + xp[:, k:k + s] * w[k]
    return y


def rope(x, pos):
    half = x.shape[-1] // 2
    inv_freq = ROPE_THETA ** (-jnp.arange(half, dtype=jnp.float32) / half)
    ang = pos.astype(jnp.float32)[:, None] * inv_freq[None, :]
    shape = (1, x.shape[1]) + (1,) * (x.ndim - 3) + (half,)
    cos = jnp.cos(ang).reshape(shape)
    sin = jnp.sin(ang).reshape(shape)
    xf = x.astype(jnp.float32)
    x1, x2 = xf[..., :half], xf[..., half:]
    return jnp.concatenate([x1 * cos - x2 * sin, x2 * cos + x1 * sin], axis=-1).astype(x.dtype)


def masked_softmax(s, mask):
    s = jnp.where(mask, s.astype(jnp.float32), NEG_INF)
    m = jnp.max(s, axis=-1, keepdims=True)
    e = jnp.where(mask, jnp.exp(s - m), 0.0)
    return e / jnp.maximum(jnp.sum(e, axis=-1, keepdims=True), 1e-30)


def segsum(a):
    t = a.shape[-1]
    ar = jnp.broadcast_to(a[..., :, None], a.shape + (t,))
    ar = jnp.where(jnp.tril(jnp.ones((t, t), dtype=bool), -1), ar, 0.0)
    cs = jnp.cumsum(ar, axis=-2)
    return jnp.where(jnp.tril(jnp.ones((t, t), dtype=bool)), cs, -jnp.inf)


def ssd_mixer(z, xbc, dt, conv_w, conv_b, dt_bias, a_log, d_skip, g_norm):
    bsz, s, _ = z.shape
    f32 = jnp.float32
    nc, cl = s // SSD_CHUNK, SSD_CHUNK
    g, j, hp, n = SSD_N_GROUPS, SSD_HPG, SSD_HEAD_DIM, SSD_D_STATE
    xbc = jax.nn.silu(causal_dwconv(xbc, conv_w, conv_b))
    xs, bm, cm = jnp.split(xbc, [SSD_D_INNER, SSD_D_INNER + g * n], axis=-1)
    xs = xs.astype(f32).reshape(bsz, nc, cl, g, j, hp)
    bm = bm.astype(f32).reshape(bsz, nc, cl, g, n)
    cm = cm.astype(f32).reshape(bsz, nc, cl, g, n)
    dt = jax.nn.softplus(dt.astype(f32) + dt_bias.astype(f32))
    a = -jnp.exp(a_log.astype(f32))
    dt_c = dt.reshape(bsz, nc, cl, g, j)
    xdt = xs * dt_c[..., None]
    a_dt = (dt_c * a.reshape(g, j)).transpose(0, 3, 4, 1, 2)
    acs = jnp.cumsum(a_dt, axis=-1)
    decay_in = jnp.exp(segsum(a_dt))
    cb = jnp.einsum('bclgn,bcsgn->bgcls', cm, bm)
    y_diag = jnp.einsum('bgjcls,bcsgjp->bclgjp', cb[:, :, None] * decay_in, xdt)

    def chunk_step(h, inp):
        c_c, b_c, xdt_c, acs_c = inp
        y_off = jnp.einsum('blgn,bgjpn,bgjl->blgjp', c_c, h, jnp.exp(acs_c))
        decay_st = jnp.exp(acs_c[..., -1:] - acs_c)
        s_c = jnp.einsum('blgn,bgjl,blgjp->bgjpn', b_c, decay_st, xdt_c)
        h = h * jnp.exp(acs_c[..., -1])[..., None, None] + s_c
        return h, y_off

    h0 = jnp.zeros((bsz, g, j, hp, n), f32)
    _, y_off = lax.scan(chunk_step, h0, (cm.transpose(1, 0, 2, 3, 4), bm.transpose(1, 0, 2, 3, 4),
                                         xdt.transpose(1, 0, 2, 3, 4, 5), acs.transpose(3, 0, 1, 2, 4)))
    y_off = y_off.transpose(1, 0, 2, 3, 4, 5)
    y = y_diag + y_off + xs * d_skip.astype(f32).reshape(g, j)[:, :, None]
    y = y.reshape(bsz, s, SSD_D_INNER)
    return rmsnorm(y * jax.nn.silu(z.astype(f32)), g_norm)


def diff_attention(q, k, v, lq1, lk1, lq2, lk2, g_norm, lambda_init):
    bsz, s, _ = q.shape
    h, dh = DIFF_N_HEADS, DIFF_HEAD_DIM
    pos = jnp.arange(s)
    q = rope(q.reshape(bsz, s, h, 2, dh), pos)
    k = rope(k.reshape(bsz, s, h, 2, dh), pos)
    v = v.reshape(bsz, s, h, DIFF_V_DIM)
    f32 = jnp.float32
    lam = (jnp.exp(jnp.sum(lq1.astype(f32) * lk1.astype(f32)))
           - jnp.exp(jnp.sum(lq2.astype(f32) * lk2.astype(f32))) + lambda_init)
    scale = dh ** -0.5
    nb = s // Q_BLOCK
    qb = q.reshape(bsz, nb, Q_BLOCK, h, 2, dh).transpose(1, 0, 2, 3, 4, 5)

    def block(args):
        q_blk, i = args
        sc = jnp.einsum('bqhmd,bkhmd->bhmqk', q_blk, k).astype(f32) * scale
        qpos = i * Q_BLOCK + jnp.arange(Q_BLOCK)
        pr = masked_softmax(sc, qpos[:, None] >= pos[None, :])
        w = pr[:, :, 0] - lam * pr[:, :, 1]
        return jnp.einsum('bhqk,bkhe->bqhe', w.astype(v.dtype), v)

    o = lax.map(block, (qb, jnp.arange(nb)))
    o = o.transpose(1, 0, 2, 3, 4).reshape(bsz, s, h, DIFF_V_DIM)
    o = rmsnorm(o, g_norm) * (1.0 - lambda_init)
    return o.reshape(bsz, s, DIFF_WIDTH)


def nsa_attention(q, k_cmp, v_cmp, k_slc, v_slc, k_win, v_win, gate_logits,
                  pos_cmp, ck_w1, ck_w2, cv_w1, cv_w2):
    bsz, s, _ = q.shape
    g, j, dh = NSA_N_KV, NSA_HPG, NSA_HEAD_DIM
    f32 = jnp.float32
    pos = jnp.arange(s)
    scale = dh ** -0.5
    q = rope(q.reshape(bsz, s, g, j, dh), pos)
    k_cmp = rope(k_cmp.reshape(bsz, s, g, dh), pos)
    k_slc = rope(k_slc.reshape(bsz, s, g, dh), pos)
    k_win = rope(k_win.reshape(bsz, s, g, dh), pos)
    v_cmp = v_cmp.reshape(bsz, s, g, dh)
    v_slc = v_slc.reshape(bsz, s, g, dh)
    v_win = v_win.reshape(bsz, s, g, dh)

    n_cmp = (s - CMP_BLOCK) // CMP_STRIDE + 1
    cidx = np.arange(n_cmp)[:, None] * CMP_STRIDE + np.arange(CMP_BLOCK)[None, :]

    def compress(t, w1, w2):
        blk = t[:, cidx] + pos_cmp[None, None, :, None, :]
        blk = blk.transpose(0, 1, 3, 2, 4).reshape(bsz, n_cmp, g, CMP_BLOCK * dh)
        return jax.nn.gelu(blk @ w1) @ w2

    kc = compress(k_cmp, ck_w1, ck_w2)
    vc = compress(v_cmp, cv_w1, cv_w2)
    s_c = jnp.einsum('bsgjd,bngd->bgjsn', q, kc).astype(f32) * scale
    mask_c = pos[:, None] >= jnp.asarray(cidx[:, -1])[None, :]
    p_c = masked_softmax(s_c, mask_c)
    o_cmp = jnp.einsum('bgjsn,bngd->bsgjd', p_c.astype(vc.dtype), vc)

    n_sel = s // SEL_BLOCK
    topk = min(SEL_TOPK, n_sel)
    cs = np.arange(n_cmp)[:, None] * CMP_STRIDE
    ss = np.arange(n_sel)[None, :] * SEL_BLOCK
    overlap = np.clip(np.minimum(cs + CMP_BLOCK, ss + SEL_BLOCK) - np.maximum(cs, ss), 0, None) / CMP_BLOCK
    imp = jnp.einsum('bgjsn,nm->bgsm', p_c, jnp.asarray(overlap, f32))
    cur = pos // SEL_BLOCK
    blk_ids = jnp.arange(n_sel)
    forced = (blk_ids[None, :] == cur[:, None]) | (blk_ids[None, :] == 0)
    future = blk_ids[None, :] > cur[:, None]
    imp = jnp.where(forced, FORCE_SCORE, jnp.where(future, NEG_INF, imp))
    _, sel_idx = lax.top_k(imp, topk)
    ks_blocks = k_slc.reshape(bsz, n_sel, SEL_BLOCK, g, dh).transpose(0, 3, 1, 2, 4)
    vs_blocks = v_slc.reshape(bsz, n_sel, SEL_BLOCK, g, dh).transpose(0, 3, 1, 2, 4)
    gather_blocks = jax.vmap(jax.vmap(lambda kb, ib: kb[ib]))
    nqb = s // SEL_BLOCK
    q_sb = q.reshape(bsz, nqb, SEL_BLOCK, g, j, dh).transpose(1, 0, 2, 3, 4, 5)
    idx_sb = sel_idx.reshape(bsz, g, nqb, SEL_BLOCK, topk).transpose(2, 0, 1, 3, 4)

    def sel_block(args):
        q_blk, idx_blk, i = args
        kg = gather_blocks(ks_blocks, idx_blk)
        vg = gather_blocks(vs_blocks, idx_blk)
        sc = jnp.einsum('bqgjd,bgqkld->bgjqkl', q_blk, kg).astype(f32) * scale
        qpos = i * SEL_BLOCK + jnp.arange(SEL_BLOCK)
        kpos = idx_blk[..., None] * SEL_BLOCK + jnp.arange(SEL_BLOCK)
        mask = (kpos <= qpos[None, None, :, None, None])[:, :, None]
        sc = sc.reshape(bsz, g, j, SEL_BLOCK, topk * SEL_BLOCK)
        mask = mask.reshape(bsz, g, 1, SEL_BLOCK, topk * SEL_BLOCK)
        pr = masked_softmax(sc, mask)
        vg = vg.reshape(bsz, g, SEL_BLOCK, topk * SEL_BLOCK, dh)
        return jnp.einsum('bgjqt,bgqtd->bqgjd', pr.astype(vg.dtype), vg)

    o_slc = lax.map(sel_block, (q_sb, idx_sb, jnp.arange(nqb)))
    o_slc = o_slc.transpose(1, 0, 2, 3, 4, 5).reshape(bsz, s, g, j, dh)

    nwb = s // Q_BLOCK
    span = WINDOW + Q_BLOCK
    kw_pad = jnp.pad(k_win, ((0, 0), (WINDOW, 0), (0, 0), (0, 0)))
    vw_pad = jnp.pad(v_win, ((0, 0), (WINDOW, 0), (0, 0), (0, 0)))
    q_wb = q.reshape(bsz, nwb, Q_BLOCK, g, j, dh).transpose(1, 0, 2, 3, 4, 5)

    def win_block(args):
        q_blk, i = args
        start = i * Q_BLOCK
        kb = lax.dynamic_slice_in_dim(kw_pad, start, span, axis=1)
        vb = lax.dynamic_slice_in_dim(vw_pad, start, span, axis=1)
        sc = jnp.einsum('bqgjd,bkgd->bgjqk', q_blk, kb).astype(f32) * scale
        qpos = start + jnp.arange(Q_BLOCK)
        kpos = start - WINDOW + jnp.arange(span)
        diff = qpos[:, None] - kpos[None, :]
        mask = (diff >= 0) & (diff < WINDOW) & (kpos[None, :] >= 0)
        pr = masked_softmax(sc, mask)
        return jnp.einsum('bgjqk,bkgd->bqgjd', pr.astype(vb.dtype), vb)

    o_win = lax.map(win_block, (q_wb, jnp.arange(nwb)))
    o_win = o_win.transpose(1, 0, 2, 3, 4, 5).reshape(bsz, s, g, j, dh)

    gates = jax.nn.sigmoid(gate_logits.astype(f32)).reshape(bsz, s, g, j, 3)
    o = (gates[..., 0:1] * o_cmp.astype(f32) + gates[..., 1:2] * o_slc.astype(f32)
         + gates[..., 2:3] * o_win.astype(f32))
    return o.reshape(bsz, s, NSA_WIDTH)


def _lru_combine(c1, c2):
    a1, b1 = c1
    a2, b2 = c2
    return a1 * a2, a2 * b1 + b2


def rglru_mixer(gate_in, x_in, conv_w, conv_b, w_r, b_r, w_i, b_i, lam):
    bsz, s, _ = x_in.shape
    f32 = jnp.float32
    xc = causal_dwconv(x_in, conv_w, conv_b)
    xb = xc.reshape(bsz, s, RNN_BLOCKS, RNN_BLOCK_DIM)
    r = jax.nn.sigmoid(jnp.einsum('bshi,hio->bsho', xb, w_r).reshape(bsz, s, RNN_WIDTH).astype(f32) + b_r)
    ig = jax.nn.sigmoid(jnp.einsum('bshi,hio->bsho', xb, w_i).reshape(bsz, s, RNN_WIDTH).astype(f32) + b_i)
    log_a = -RG_C * r * jax.nn.softplus(-lam.astype(f32))
    a = jnp.exp(log_a)
    u = jnp.sqrt(-jnp.expm1(2.0 * log_a)) * (ig * xc.astype(f32))
    _, hs = lax.associative_scan(_lru_combine, (a, u), axis=1)
    return hs * jax.nn.gelu(gate_in.astype(f32))


def setup_inputs(seed: int = 0) -> dict:
    key = jax.random.key(seed)
    ks = iter(jax.random.split(key, 64))
    f32 = jnp.float32
    L = DEPTH

    def nrm(shape, scale):
        return jax.random.normal(next(ks), shape, f32) * scale

    def gain(shape):
        return 1.0 + 0.02 * jax.random.normal(next(ks), shape, f32)

    dt0 = jnp.exp(jax.random.uniform(next(ks), (L, SSD_N_HEADS), f32, math.log(1e-3), math.log(1e-1)))
    a0 = jax.random.uniform(next(ks), (L, RNN_WIDTH), f32, 0.9, 0.999)
    return {
        'x': nrm((BATCH, SEQ, D_MODEL), 1.0),
        'p': nrm((L, BATCH, SEQ, PLE_DIM), 1.0),
        'norm_mix': gain((L, D_MODEL)),
        'norm_ffn': gain((L, D_MODEL)),
        'norm_ple': gain((L, D_MODEL)),
        'w_in': nrm((L, D_MODEL, D_IN), D_MODEL ** -0.5),
        'ssd_conv_w': nrm((L, SSD_CONV, SSD_CONV_DIM), SSD_CONV ** -0.5),
        'ssd_conv_b': nrm((L, SSD_CONV_DIM), 0.02),
        'ssd_dt_bias': dt0 + jnp.log(-jnp.expm1(-dt0)),
        'ssd_a_log': jnp.log(jax.random.uniform(next(ks), (L, SSD_N_HEADS), f32, 1.0, 16.0)),
        'ssd_d': gain((L, SSD_N_HEADS)),
        'ssd_norm': gain((L, SSD_D_INNER)),
        'diff_lq1': nrm((L, DIFF_HEAD_DIM), 0.1),
        'diff_lk1': nrm((L, DIFF_HEAD_DIM), 0.1),
        'diff_lq2': nrm((L, DIFF_HEAD_DIM), 0.1),
        'diff_lk2': nrm((L, DIFF_HEAD_DIM), 0.1),
        'diff_norm': gain((L, DIFF_V_DIM)),
        'nsa_pos_cmp': nrm((L, CMP_BLOCK, NSA_HEAD_DIM), 0.02),
        'nsa_ck_w1': nrm((L, CMP_BLOCK * NSA_HEAD_DIM, CMP_HIDDEN), (CMP_BLOCK * NSA_HEAD_DIM) ** -0.5),
        'nsa_ck_w2': nrm((L, CMP_HIDDEN, NSA_HEAD_DIM), CMP_HIDDEN ** -0.5),
        'nsa_cv_w1': nrm((L, CMP_BLOCK * NSA_HEAD_DIM, CMP_HIDDEN), (CMP_BLOCK * NSA_HEAD_DIM) ** -0.5),
        'nsa_cv_w2': nrm((L, CMP_HIDDEN, NSA_HEAD_DIM), CMP_HIDDEN ** -0.5),
        'rnn_conv_w': nrm((L, RNN_CONV, RNN_WIDTH), RNN_CONV ** -0.5),
        'rnn_conv_b': nrm((L, RNN_WIDTH), 0.02),
        'rnn_w_r': nrm((L, RNN_BLOCKS, RNN_BLOCK_DIM, RNN_BLOCK_DIM), RNN_BLOCK_DIM ** -0.5),
        'rnn_b_r': nrm((L, RNN_WIDTH), 0.02),
        'rnn_w_i': nrm((L, RNN_BLOCKS, RNN_BLOCK_DIM, RNN_BLOCK_DIM), RNN_BLOCK_DIM ** -0.5),
        'rnn_b_i': nrm((L, RNN_WIDTH), 0.02),
        'rnn_lambda': jnp.log(a0) - jnp.log1p(-a0),
        'w_merge_gate': nrm((L, N_BRANCH, D_MODEL, D_MODEL), D_MODEL ** -0.5),
        'w_branch': nrm((L, N_BRANCH, MIX_WIDTH, D_MODEL), MIX_WIDTH ** -0.5),
        'w_out': nrm((L, D_MODEL, D_MODEL), D_MODEL ** -0.5),
        'ffn_w_up': nrm((L, D_MODEL, 2 * D_FF), D_MODEL ** -0.5),
        'ffn_conv_w': nrm((L, FFN_CONV, 2 * D_FF), FFN_CONV ** -0.5),
        'ffn_conv_b': nrm((L, 2 * D_FF), 0.02),
        'ffn_w_down': nrm((L, D_FF, D_MODEL), D_FF ** -0.5),
        'ple_w_proj': nrm((L, PLE_DIM, D_MODEL), PLE_DIM ** -0.5),
        'ple_w_gate': nrm((L, D_MODEL, D_MODEL), D_MODEL ** -0.5),
        'norm_final': gain((D_MODEL,)),
    }


def reference(x, p, norm_mix, norm_ffn, norm_ple, w_in,
              ssd_conv_w, ssd_conv_b, ssd_dt_bias, ssd_a_log, ssd_d, ssd_norm,
              diff_lq1, diff_lk1, diff_lq2, diff_lk2, diff_norm,
              nsa_pos_cmp, nsa_ck_w1, nsa_ck_w2, nsa_cv_w1, nsa_cv_w2,
              rnn_conv_w, rnn_conv_b, rnn_w_r, rnn_b_r, rnn_w_i, rnn_b_i, rnn_lambda,
              w_merge_gate, w_branch, w_out,
              ffn_w_up, ffn_conv_w, ffn_conv_b, ffn_w_down,
              ple_w_proj, ple_w_gate, norm_final):
    f32 = jnp.float32
    for l in range(DEPTH):
        h = rmsnorm(x, norm_mix[l])
        proj = h @ w_in[l]
        (a_z, a_xbc, a_dt, b_q, b_k, b_v, c_q, c_kc, c_vc, c_ks, c_vs, c_kw, c_vw, c_g,
         d_gate, d_x) = jnp.split(proj, list(IN_OFFSETS), axis=-1)
        o_a = ssd_mixer(a_z, a_xbc, a_dt, ssd_conv_w[l], ssd_conv_b[l], ssd_dt_bias[l],
                        ssd_a_log[l], ssd_d[l], ssd_norm[l])
        o_b = diff_attention(b_q, b_k, b_v, diff_lq1[l], diff_lk1[l], diff_lq2[l], diff_lk2[l],
                             diff_norm[l], 0.8 - 0.6 * math.exp(-0.3 * l))
        o_c = nsa_attention(c_q, c_kc, c_vc, c_ks, c_vs, c_kw, c_vw, c_g, nsa_pos_cmp[l],
                            nsa_ck_w1[l], nsa_ck_w2[l], nsa_cv_w1[l], nsa_cv_w2[l])
        o_d = rglru_mixer(d_gate, d_x, rnn_conv_w[l], rnn_conv_b[l], rnn_w_r[l], rnn_b_r[l],
                          rnn_w_i[l], rnn_b_i[l], rnn_lambda[l])
        merged = jnp.zeros(x.shape, f32)
        for n, o in enumerate((o_a, o_b, o_c, o_d)):
            gate = jax.nn.sigmoid((h @ w_merge_gate[l, n]).astype(f32))
            merged = merged + gate * (o.astype(x.dtype) @ w_branch[l, n]).astype(f32)
        x = x + (merged.astype(x.dtype) @ w_out[l]).astype(x.dtype)
        h = rmsnorm(x, norm_ffn[l])
        u = causal_dwconv(h @ ffn_w_up[l], ffn_conv_w[l], ffn_conv_b[l])
        u_gate, u_val = jnp.split(u, 2, axis=-1)
        x = x + ((jax.nn.gelu(u_gate) * u_val) @ ffn_w_down[l]).astype(x.dtype)
        g_ple = jax.nn.sigmoid((rmsnorm(x, norm_ple[l]) @ ple_w_gate[l]).astype(f32))
        x = x + (g_ple * (p[l] @ ple_w_proj[l]).astype(f32)).astype(x.dtype)
    return rmsnorm(x, norm_final)
```

```cpp
#include <hip/hip_runtime.h>
#include <hip/hip_cooperative_groups.h>
#include <cstdio>
namespace cg = cooperative_groups;

typedef unsigned short bf16_t;
typedef short bf16x8 __attribute__((ext_vector_type(8)));
typedef short s16x4 __attribute__((ext_vector_type(4)));
typedef float f32x4 __attribute__((ext_vector_type(4)));
typedef unsigned u32x4 __attribute__((ext_vector_type(4)));
typedef unsigned u32x2 __attribute__((ext_vector_type(2)));
#define LAS __attribute__((address_space(3)))

#ifndef ONE_LAUNCH
#define ONE_LAUNCH 1
#endif

constexpr int T_ = 16384, S_ = 2048, LDP = 10496;
constexpr int A_Z = 0, A_XBC = 1024, A_DT = 2560, B_Q = 2576, B_K = 3600, B_V = 4624, C_Q = 5648, C_KC = 6672, C_VC = 6928,
              C_KS = 7184, C_VS = 7440, C_KW = 7696, C_VW = 7952, C_G = 8208, D_GATE = 8256, D_X = 9280;
constexpr size_t MiB = 1u << 20;
constexpr size_t OFF_W = 0, OFF_H = 100 * MiB, OFF_O2 = 164 * MiB, OFF_BIG = 356 * MiB, OFF_TT = 684 * MiB, OFF_PS = 852 * MiB, WS_END = 853 * MiB;
constexpr size_t W_IN = OFF_W, W_G = W_IN + 41 * MiB, W_B = W_G + 32 * MiB, W_OUT = W_B + 16 * MiB, W_RG = W_OUT + 8 * MiB, W_C1 = W_RG + 1 * MiB;
constexpr size_t O_O = OFF_O2, O_MERGED = OFF_O2 + 128 * MiB, O_ACT = OFF_O2, O_PP = OFF_O2;
constexpr size_t T_XBC = OFF_TT, T_XC = OFF_TT + 48 * MiB, T_KCVC = OFF_TT + 80 * MiB, T_LA = OFF_TT + 97 * MiB, T_UU = OFF_TT + 129 * MiB,
                 T_DT = OFF_TT + 161 * MiB, T_HID = OFF_TT + 162 * MiB, T_KC2 = OFF_TT + 166 * MiB, T_VC2 = T_KC2 + 512 * 1024;
constexpr size_t W_UP = OFF_TT + 56 * MiB, W_DN = OFF_TT + 104 * MiB, W_PG = OFF_TT + 128 * MiB, W_PP = OFF_TT + 136 * MiB, W_PB = OFF_TT + 137 * MiB;
constexpr size_t PS_ROPE = OFF_PS, PS_SELM = OFF_PS + 512 * 1024, PS_C1 = OFF_PS + 768 * 1024, PS_CTR = OFF_PS + 800 * 1024, PS_SPL = OFF_PS + 804 * 1024;
constexpr int LDS_BYTES = 147456, LDS_MISC = 131072;

struct Params { const float* in[39]; float* X; unsigned char* ws; };
typedef const Params __attribute__((address_space(4)))* KP;

__device__ __forceinline__ float bf2f(bf16_t v) { return __uint_as_float(((unsigned)v) << 16); }
__device__ __forceinline__ bf16_t f2bf(float f) { unsigned u = __float_as_uint(f); u += 0x7FFFu + ((u >> 16) & 1u); return (bf16_t)(u >> 16); }
__device__ __forceinline__ unsigned pk2(float lo, float hi) { return (unsigned)f2bf(lo) | ((unsigned)f2bf(hi) << 16); }
__device__ __forceinline__ float sigm(float x) { return 1.f / (1.f + __expf(-x)); }
__device__ __forceinline__ float gelu_t(float x) { float u = 1.5957691216f * (x + 0.044715f * x * x * x); return x / (1.f + __expf(-u)); }
__device__ __forceinline__ float softplus_(float x) { return x > 20.f ? x : __logf(1.f + __expf(x)); }
__device__ __forceinline__ float silu_(float x) { return x / (1.f + __expf(-x)); }

namespace pg8 {
constexpr int BM = 256, BK = 64, HALF = 128, HTB = HALF * BK * 2, NXCD = 8, WGM = 8;
__device__ __forceinline__ int lds_byte(int r, int c) { const int st = (r >> 4) * 2 + (c >> 5), rr = r & 15, cc = c & 31, ob = rr * 64 + cc * 2; return st * 1024 + (ob ^ (((ob >> 9) & 1) << 5)); }
__device__ __forceinline__ void stage_rc(int b, int& R, int& C) { const int st = b / 1024, sb = b % 1024, swz = sb ^ (((sb >> 9) & 1) << 5); R = (st >> 1) * 16 + swz / 64; C = (st & 1) * 32 + (swz % 64) / 2; }
__device__ __forceinline__ int perm32(int rho) { const int n = rho >> 4, i = rho & 15; return 8 * (i >> 2) + 4 * n + (i & 3); }
struct Unit { int pm, pn, ka; };
struct Gemm { const bf16_t* A; const bf16_t* Bt; int lda, K; };
struct Order {
    int nM, nN, nsub, G, c, kmode;
    __device__ void init(int nM_, int nN_, int nsub_, int G_, int c_, int kmode_) { nM = nM_; nN = nN_; nsub = nsub_; G = G_; c = c_; kmode = kmode_; }
    __device__ bool next(int i, Unit& u) const {
        const int nwg = nM * nN; const int L = i * G + c; if (L >= nwg * nsub) return false;
        const int sub = L / nwg; int wgid = L - sub * nwg;
        { const int q = nwg / NXCD, r = nwg % NXCD, xcd = wgid % NXCD, off = wgid / NXCD; wgid = (xcd < r ? xcd * (q + 1) : r * (q + 1) + (xcd - r) * q) + off; }
        const int nig = WGM * nN, gid = wgid / nig, fm = gid * WGM, gsz = (nM - fm) < WGM ? (nM - fm) : WGM;
        const int pm0 = fm + ((wgid % nig) % gsz), pn0 = (wgid % nig) / gsz;
        u.pm = __builtin_amdgcn_readfirstlane(sub * nM + pm0); u.pn = __builtin_amdgcn_readfirstlane(sub * nN + pn0); u.ka = __builtin_amdgcn_readfirstlane(kmode ? 256 * (pn0 >> 1) : 0); return true;
    }
};

template <int lda, int K, class Epi>
__device__ __forceinline__ void gemm_phase(int tidv, int bidv, LAS unsigned char* lds, const bf16_t* gA, const bf16_t* gBt, const Order& S, const Epi& E) {
    const int tid = tidv, wid = __builtin_amdgcn_readfirstlane(tid >> 6), lane = tid & 63, wr = wid >> 2, wc = wid & 3, fr = lane & 15, fq = lane >> 4;
    constexpr int nt = K / BK;
    unsigned voffA[2], voffB[2];
#pragma unroll
    for (int i = 0; i < 2; ++i) { int R, C; stage_rc(tid * 16 + i * 8192, R, C); const int Rb = Epi::PERM ? ((R & ~31) + perm32(R & 31)) : R;
        voffA[i] = (unsigned)(R * lda + C) * 2u; voffB[i] = (unsigned)(Rb * K + C) * 2u; }
    constexpr size_t kstep = (size_t)(BK * 2);
    constexpr size_t hstepA = (size_t)HALF * lda * 2, hstepB = (size_t)HALF * K * 2;
    constexpr size_t tstepA = 2 * hstepA, tstepB = 2 * hstepB;
    const unsigned ldsw = (unsigned)wid * 1024u;
    const int aoff = lds_byte(wr * 64 + fr, fq * 8), boff = lds_byte(wc * 32 + fr, fq * 8);
#define PG8_SA(b, h) (((b) * 2 + (h)) * HTB)
#define PG8_SB(b, h) ((4 + (b) * 2 + (h)) * HTB)
#define PG8_STAGE(bufoff, gbase, voff) do { _Pragma("unroll") for (int _i = 0; _i < 2; ++_i) \
        __builtin_amdgcn_global_load_lds((const unsigned*)((const char*)(gbase) + (voff)[_i]), (LAS unsigned*)(lds + (bufoff) + ldsw + _i * 8192), 16, 0, 0); } while (0)
#define PG8_LDA(dst, b, h) do { _Pragma("unroll") for (int m = 0; m < 4; ++m) _Pragma("unroll") for (int k = 0; k < 2; ++k) dst[m][k] = *(const LAS bf16x8*)(lds + PG8_SA(b, h) + aoff + m * 2048 + k * 1024); } while (0)
#define PG8_LDB(dst, b, h) do { _Pragma("unroll") for (int n = 0; n < 2; ++n) _Pragma("unroll") for (int k = 0; k < 2; ++k) dst[n][k] = *(const LAS bf16x8*)(lds + PG8_SB(b, h) + boff + n * 2048 + k * 1024); } while (0)
#define PG8_MMA(ai, bj, At, Bt) do { __builtin_amdgcn_s_setprio(1); _Pragma("unroll") for (int m = 0; m < 4; ++m) _Pragma("unroll") for (int n = 0; n < 2; ++n) _Pragma("unroll") for (int k = 0; k < 2; ++k) \
        acc[ai][bj][m][n] = __builtin_amdgcn_mfma_f32_16x16x32_bf16(Bt[n][k], At[m][k], acc[ai][bj][m][n], 0, 0, 0); __builtin_amdgcn_s_setprio(0); } while (0)
#define PG8_WAIT_V(n) asm volatile("s_waitcnt vmcnt(" #n ")" ::: "memory")
#define PG8_WAIT_L(n) asm volatile("s_waitcnt lgkmcnt(" #n ")" ::: "memory")
#define PG8_BAR __builtin_amdgcn_s_barrier()
#define PG8_SCHED __builtin_amdgcn_sched_barrier(0)
    Unit cur, nxt; int ui = 0;
    if (!S.next(0, cur)) return;
    f32x4 acc[2][2][4][2];
#pragma unroll
    for (int a = 0; a < 2; ++a)
#pragma unroll
        for (int b = 0; b < 2; ++b)
#pragma unroll
            for (int m = 0; m < 4; ++m)
#pragma unroll
                for (int n = 0; n < 2; ++n) acc[a][b][m][n] = (f32x4){0.f, 0.f, 0.f, 0.f};
    bf16x8 At[4][2], B0[2][2], B1[2][2];
    const char* cA = (const char*)gA + (size_t)cur.pm * tstepA + (size_t)cur.ka * 2; const char* cB = (const char*)gBt + (size_t)cur.pn * tstepB;
    PG8_STAGE(PG8_SB(0, 0), cB, voffB); PG8_STAGE(PG8_SA(0, 0), cA, voffA); PG8_STAGE(PG8_SB(0, 1), cB + hstepB, voffB); PG8_STAGE(PG8_SA(0, 1), cA + hstepA, voffA);
    if (wr == 1) PG8_BAR;
    PG8_WAIT_V(4); PG8_BAR;
    PG8_STAGE(PG8_SB(1, 0), cB + kstep, voffB); PG8_STAGE(PG8_SA(1, 0), cA + kstep, voffA); PG8_STAGE(PG8_SB(1, 1), cB + hstepB + kstep, voffB);
    PG8_WAIT_V(6); PG8_BAR;
    for (;;) {
        const bool has_next = S.next(ui + 1, nxt);
        const char* nA = has_next ? (const char*)gA + (size_t)nxt.pm * tstepA + (size_t)nxt.ka * 2 : cA; const char* nB = has_next ? (const char*)gBt + (size_t)nxt.pn * tstepB : cB;
#pragma unroll 1
        for (int t = 0; t < nt; t += 2) {
            const bool last = (t == nt - 2);
            const char* a1 = cA + (size_t)(t + 1) * kstep;
            const char* a2 = last ? nA : cA + (size_t)(t + 2) * kstep; const char* b2 = last ? nB : cB + (size_t)(t + 2) * kstep;
            const char* a3 = a2 + kstep; const char* b3 = b2 + kstep;
            PG8_LDB(B0, 0, 0); PG8_SCHED; PG8_LDA(At, 0, 0); PG8_STAGE(PG8_SA(1, 1), a1 + hstepA, voffA);
            PG8_WAIT_L(8); PG8_BAR; PG8_WAIT_L(0); PG8_MMA(0, 0, At, B0); PG8_BAR; PG8_SCHED;
            PG8_LDB(B1, 0, 1); PG8_STAGE(PG8_SB(0, 0), b2, voffB);
            PG8_BAR; PG8_WAIT_L(0); PG8_MMA(0, 1, At, B1); PG8_BAR;
            PG8_LDA(At, 0, 1); PG8_STAGE(PG8_SA(0, 0), a2, voffA);
            PG8_BAR; PG8_WAIT_L(0); PG8_MMA(1, 0, At, B0); PG8_BAR; PG8_SCHED;
            PG8_STAGE(PG8_SB(0, 1), b2 + hstepB, voffB);
            PG8_WAIT_V(6); PG8_BAR; PG8_MMA(1, 1, At, B1); PG8_BAR;
            PG8_LDB(B0, 1, 0); PG8_SCHED; PG8_LDA(At, 1, 0); PG8_STAGE(PG8_SA(0, 1), a2 + hstepA, voffA);
            PG8_WAIT_L(8); PG8_BAR; PG8_WAIT_L(0); PG8_MMA(0, 0, At, B0); PG8_BAR; PG8_SCHED;
            PG8_LDB(B1, 1, 1); PG8_STAGE(PG8_SB(1, 0), b3, voffB);
            PG8_BAR; PG8_WAIT_L(0); PG8_MMA(0, 1, At, B1); PG8_BAR;
            PG8_LDA(At, 1, 1); PG8_STAGE(PG8_SA(1, 0), a3, voffA);
            PG8_BAR; PG8_WAIT_L(0); PG8_MMA(1, 0, At, B0); PG8_BAR; PG8_SCHED;
            PG8_STAGE(PG8_SB(1, 1), b3 + hstepB, voffB);
            PG8_WAIT_V(6); PG8_BAR; PG8_MMA(1, 1, At, B1); PG8_BAR;
        }
        E(acc, cur, wr, wc, fr, fq);
        if (!has_next) break;
#pragma unroll
        for (int a = 0; a < 2; ++a)
#pragma unroll
            for (int b = 0; b < 2; ++b)
#pragma unroll
                for (int m = 0; m < 4; ++m)
#pragma unroll
                    for (int n = 0; n < 2; ++n) acc[a][b][m][n] = (f32x4){0.f, 0.f, 0.f, 0.f};
        cur = nxt; cA = nA; cB = nB; ++ui;
    }
    PG8_WAIT_V(0);
    if (wr == 0) PG8_BAR;
    PG8_BAR;
#undef PG8_SA
#undef PG8_SB
#undef PG8_STAGE
#undef PG8_LDA
#undef PG8_LDB
#undef PG8_MMA
#undef PG8_WAIT_V
#undef PG8_WAIT_L
#undef PG8_BAR
#undef PG8_SCHED
}
}
using pg8::Unit;

template <bool HIDM> struct EpiBfT {
    static constexpr bool PERM = true;
    bf16_t* O; int ldc; int pnmask; const float* bias;
    __device__ __forceinline__ void operator()(const f32x4 (&acc)[2][2][4][2], const Unit& u, int wr, int wc, int fr, int fq) const {
        const int row0 = u.pm * 256 + wr * 64 + fr; const int colt = (u.pn & pnmask) * 256; const int col0 = colt + wc * 32 + 8 * fq;
#pragma unroll
        for (int ai = 0; ai < 2; ++ai)
#pragma unroll
            for (int m = 0; m < 4; ++m) { bf16_t* rowp = O + (size_t)(row0 + ai * 128 + m * 16) * ldc + col0;
#pragma unroll
                for (int bj = 0; bj < 2; ++bj) { f32x4 v0 = acc[ai][bj][m][0], v1 = acc[ai][bj][m][1];
                    if (HIDM) { const float* bp = bias + u.pn * 256 + wc * 32 + 8 * fq + bj * 128;
#pragma unroll
                        for (int e = 0; e < 4; ++e) { v0[e] = gelu_t(v0[e] + bp[e]); v1[e] = gelu_t(v1[e] + bp[4 + e]); } }
                    u32x4 w; w.x = pk2(v0[0], v0[1]); w.y = pk2(v0[2], v0[3]); w.z = pk2(v1[0], v1[1]); w.w = pk2(v1[2], v1[3]);
                    *(u32x4*)(rowp + bj * 128) = w; } }
    }
};
typedef EpiBfT<false> EpiBf; typedef EpiBfT<true> EpiHid;
struct EpiMerge {
    static constexpr bool PERM = false;
    const bf16_t* P; bf16_t* M;
    __device__ __forceinline__ void operator()(const f32x4 (&acc)[2][2][4][2], const Unit& u, int wr, int wc, int fr, int fq) const {
        const int oc = u.pn * 64 + wc * 16 + fq * 4;
#pragma unroll
        for (int ai = 0; ai < 2; ++ai)
#pragma unroll
            for (int m = 0; m < 4; ++m) { const int row = u.pm * 256 + ai * 128 + wr * 64 + m * 16 + fr;
                float r0 = 0.f, r1 = 0.f, r2 = 0.f, r3 = 0.f;
#pragma unroll
                for (int br = 0; br < 4; ++br) { const u32x2 pv = *(const u32x2*)(P + ((size_t)br * T_ + row) * 2048 + oc); const f32x4 a = acc[ai][br >> 1][m][br & 1];
                    r0 += sigm(a[0]) * bf2f((bf16_t)(pv.x & 0xffff)); r1 += sigm(a[1]) * bf2f((bf16_t)(pv.x >> 16));
                    r2 += sigm(a[2]) * bf2f((bf16_t)(pv.y & 0xffff)); r3 += sigm(a[3]) * bf2f((bf16_t)(pv.y >> 16)); }
                u32x2 w; w.x = pk2(r0, r1); w.y = pk2(r2, r3); *(u32x2*)(M + (size_t)row * 2048 + oc) = w; }
    }
};
struct EpiResid {
    static constexpr bool PERM = false;
    float* X; const bf16_t* PP;
    __device__ __forceinline__ void operator()(const f32x4 (&acc)[2][2][4][2], const Unit& u, int wr, int wc, int fr, int fq) const {
#pragma unroll
        for (int ai = 0; ai < 2; ++ai)
#pragma unroll
            for (int m = 0; m < 4; ++m) { const int row = u.pm * 256 + ai * 128 + wr * 64 + m * 16 + fr;
#pragma unroll
                for (int bj = 0; bj < 2; ++bj)
#pragma unroll
                    for (int n = 0; n < 2; ++n) { const int col = u.pn * 256 + bj * 128 + wc * 32 + n * 16 + 4 * fq; float* xp = X + (size_t)row * 2048 + col;
                        f32x4 x = *(f32x4*)xp; const f32x4 a = acc[ai][bj][m][n];
                        if (PP) { const u32x2 pv = *(const u32x2*)(PP + (size_t)row * 2048 + col);
                            x[0] += sigm(a[0]) * bf2f((bf16_t)(pv.x & 0xffff)); x[1] += sigm(a[1]) * bf2f((bf16_t)(pv.x >> 16));
                            x[2] += sigm(a[2]) * bf2f((bf16_t)(pv.y & 0xffff)); x[3] += sigm(a[3]) * bf2f((bf16_t)(pv.y >> 16)); }
                        else x += a;
                        *(f32x4*)xp = x; } }
    }
};
struct EpiRG {
    static constexpr bool PERM = false;
    const bf16_t* XC; const float* b_r; const float* b_i; const float* spl; bf16_t* LA; bf16_t* UU;
    __device__ __forceinline__ void operator()(const f32x4 (&acc)[2][2][4][2], const Unit& u, int wr, int wc, int fr, int fq) const {
#pragma unroll
        for (int n = 0; n < 2; ++n) { const int ch = u.pn * 128 + wc * 32 + n * 16 + 4 * fq;
            const f32x4 br = *(const f32x4*)(b_r + ch), bi = *(const f32x4*)(b_i + ch), sp = *(const f32x4*)(spl + ch);
#pragma unroll
            for (int ai = 0; ai < 2; ++ai)
#pragma unroll
                for (int m = 0; m < 4; ++m) { const size_t off = (size_t)(u.pm * 256 + ai * 128 + wr * 64 + m * 16 + fr) * 1024 + ch;
                    const u32x2 xv = *(const u32x2*)(XC + off);
                    const f32x4 ar = acc[ai][0][m][n], aig = acc[ai][1][m][n];
                    const float l0 = sp[0] * sigm(ar[0] + br[0]), l1 = sp[1] * sigm(ar[1] + br[1]), l2 = sp[2] * sigm(ar[2] + br[2]), l3 = sp[3] * sigm(ar[3] + br[3]);
                    u32x2 w; w.x = pk2(l0, l1); w.y = pk2(l2, l3); *(u32x2*)(LA + off) = w;
                    const float u0 = sqrtf(fmaxf(1.f - __expf(2.f * l0), 0.f)) * sigm(aig[0] + bi[0]) * bf2f((bf16_t)(xv.x & 0xffff));
                    const float u1 = sqrtf(fmaxf(1.f - __expf(2.f * l1), 0.f)) * sigm(aig[1] + bi[1]) * bf2f((bf16_t)(xv.x >> 16));
                    const float u2 = sqrtf(fmaxf(1.f - __expf(2.f * l2), 0.f)) * sigm(aig[2] + bi[2]) * bf2f((bf16_t)(xv.y & 0xffff));
                    const float u3 = sqrtf(fmaxf(1.f - __expf(2.f * l3), 0.f)) * sigm(aig[3] + bi[3]) * bf2f((bf16_t)(xv.y >> 16));
                    w.x = pk2(u0, u1); w.y = pk2(u2, u3); *(u32x2*)(UU + off) = w; } }
    }
};

template <class F>
__device__ __forceinline__ void convT(int tidv, int bidv, const F& rowsrc, int K, int ld, bf16_t* dst, int nrows, LAS float* tile) {
    const int tid = tidv, nkt = K >> 6, ntiles = (nrows >> 6) * nkt;
    for (int tl = bidv; tl < ntiles; tl += gridDim.x) {
        const int rt = tl / nkt, kt = tl - rt * nkt;
        { const int jj = tid & 63, kk0 = tid >> 6; const float* src = rowsrc(rt * 64 + jj);
#pragma unroll
            for (int i = 0; i < 8; ++i) { const int kk = kk0 + 8 * i; tile[kk * 65 + jj] = src ? src[(size_t)(kt * 64 + kk) * ld] : 0.f; } }
        __syncthreads();
        { const int kk = tid & 63, jj0 = tid >> 6;
#pragma unroll
            for (int i = 0; i < 8; ++i) { const int jj = jj0 + 8 * i; dst[(size_t)(rt * 64 + jj) * K + kt * 64 + kk] = f2bf(tile[kk * 65 + jj]); } }
        __syncthreads();
    }
}
__device__ __forceinline__ void rms_rows(int tidv, int bidv, const float* Xin, const float* g, bf16_t* H, float* Xc) {
    const int lane = tidv & 63, wv = tidv >> 6;
    for (int row = bidv * 8 + wv; row < T_; row += gridDim.x * 8) {
        const float* xr = Xin + (size_t)row * 2048; f32x4 v[8]; float ss = 0.f;
#pragma unroll
        for (int i = 0; i < 8; ++i) { v[i] = *(const f32x4*)(xr + i * 256 + lane * 4); ss += v[i][0] * v[i][0] + v[i][1] * v[i][1] + v[i][2] * v[i][2] + v[i][3] * v[i][3]; }
#pragma unroll
        for (int o = 32; o >= 1; o >>= 1) ss += __shfl_xor(ss, o);
        const float rs = rsqrtf(ss * (1.0f / 2048.0f) + 1e-6f);
#pragma unroll
        for (int i = 0; i < 8; ++i) { const f32x4 gg = *(const f32x4*)(g + i * 256 + lane * 4); u32x2 w; w.x = pk2(v[i][0] * rs * gg[0], v[i][1] * rs * gg[1]); w.y = pk2(v[i][2] * rs * gg[2], v[i][3] * rs * gg[3]);
            *(u32x2*)(H + (size_t)row * 2048 + i * 256 + lane * 4) = w; if (Xc) *(f32x4*)(Xc + (size_t)row * 2048 + i * 256 + lane * 4) = v[i]; }
    }
}

__constant__ double kInvFreqRev[32] = {0.15915494309189535, 0.11934937021124886, 0.08949940160889101, 0.06711508300522726, 0.050329212104487035, 0.03774158471741977, 0.0283021958306234, 0.02122365276477766, 0.015915494309189534, 0.011934937021124886, 0.008949940160889102, 0.006711508300522725, 0.005032921210448704, 0.003774158471741977, 0.00283021958306234, 0.0021223652764777662, 0.0015915494309189536, 0.0011934937021124885, 0.0008949940160889102, 0.0006711508300522726, 0.0005032921210448703, 0.00037741584717419774, 0.00028302195830623395, 0.0002122365276477766, 0.00015915494309189535, 0.00011934937021124886, 8.949940160889102e-05, 6.711508300522725e-05, 5.0329212104487035e-05, 3.774158471741978e-05, 2.8302195830623396e-05, 2.122365276477766e-05};
constexpr float LOG2E = 1.4426950408889634f;
__device__ __forceinline__ s16x4 tr_read(const LAS bf16_t* p) { return __builtin_amdgcn_ds_read_tr16_b64_v4i16((LAS s16x4*)p); }
__device__ __forceinline__ void stage_rows(int tidv, LAS bf16_t* dst, int ldd, const bf16_t* src, size_t lds_, int nrows, int ncols) {
    const int cpr = ncols >> 3, n = nrows * cpr;
    for (int idx = tidv; idx < n; idx += 512) { const int r = idx / cpr, sg = idx - r * cpr;
        const u32x4 v = *(const u32x4*)(src + (size_t)r * lds_ + sg * 8); *(LAS u32x4*)(dst + r * ldd + sg * 8) = v; }
}
__device__ __forceinline__ void qk_tile(const LAS bf16_t* Ks, const bf16x8 (&qf)[2], f32x4 (&s)[4], int li, int lg) {
#pragma unroll
    for (int kt = 0; kt < 4; ++kt) { s[kt] = (f32x4){0.f, 0.f, 0.f, 0.f};
#pragma unroll
        for (int ks = 0; ks < 2; ++ks) { const bf16x8 kf = *(const LAS bf16x8*)(Ks + (kt * 16 + li) * 72 + ks * 32 + lg * 8); s[kt] = __builtin_amdgcn_mfma_f32_16x16x32_bf16(kf, qf[ks], s[kt], 0, 0, 0); } }
}
template <int DV, int VLD>
__device__ __forceinline__ void pv_tile(const LAS bf16_t* Vs, const f32x4 (&p)[4], f32x4 (&o)[DV / 16], int li, int lg) {
#pragma unroll
    for (int kp = 0; kp < 2; ++kp) {
        bf16x8 pf;
        { const unsigned a0 = pk2(p[2 * kp][0], p[2 * kp][1]), a1 = pk2(p[2 * kp][2], p[2 * kp][3]), a2 = pk2(p[2 * kp + 1][0], p[2 * kp + 1][1]), a3 = pk2(p[2 * kp + 1][2], p[2 * kp + 1][3]);
          pf[0] = (short)(a0 & 0xffff); pf[1] = (short)(a0 >> 16); pf[2] = (short)(a1 & 0xffff); pf[3] = (short)(a1 >> 16); pf[4] = (short)(a2 & 0xffff); pf[5] = (short)(a2 >> 16); pf[6] = (short)(a3 & 0xffff); pf[7] = (short)(a3 >> 16); }
#pragma unroll
        for (int mt = 0; mt < DV / 16; ++mt) {
            const s16x4 v0 = tr_read(Vs + ((2 * kp) * 16 + lg * 4 + (li >> 2)) * VLD + mt * 16 + (li & 3) * 4);
            const s16x4 v1 = tr_read(Vs + ((2 * kp + 1) * 16 + lg * 4 + (li >> 2)) * VLD + mt * 16 + (li & 3) * 4);
            bf16x8 vf; vf[0] = v0[0]; vf[1] = v0[1]; vf[2] = v0[2]; vf[3] = v0[3]; vf[4] = v1[0]; vf[5] = v1[1]; vf[6] = v1[2]; vf[7] = v1[3];
            o[mt] = __builtin_amdgcn_mfma_f32_16x16x32_bf16(vf, pf, o[mt], 0, 0, 0);
        }
    }
}
template <int DV, int VLD, class MF>
__device__ __forceinline__ void attn_tile(const LAS bf16_t* Ks, const LAS bf16_t* Vs, const bf16x8 (&qf)[2], f32x4 (&o)[DV / 16], float& m, float& l, int li, int lg, const MF& valid) {
    f32x4 s[4]; qk_tile(Ks, qf, s, li, lg);
    float mx = -1e30f;
#pragma unroll
    for (int kt = 0; kt < 4; ++kt)
#pragma unroll
        for (int j = 0; j < 4; ++j) { const float sv = valid(kt * 16 + lg * 4 + j) ? s[kt][j] * LOG2E : -1e30f; s[kt][j] = sv; mx = fmaxf(mx, sv); }
    mx = fmaxf(mx, __shfl_xor(mx, 16)); mx = fmaxf(mx, __shfl_xor(mx, 32));
    const float mn = fmaxf(m, mx), alpha = __builtin_amdgcn_exp2f(m - mn); m = mn;
    float ps = 0.f;
#pragma unroll
    for (int kt = 0; kt < 4; ++kt)
#pragma unroll
        for (int j = 0; j < 4; ++j) { const float pv = (s[kt][j] > -1e29f) ? __builtin_amdgcn_exp2f(s[kt][j] - mn) : 0.f; s[kt][j] = pv; ps += pv; }
    l = l * alpha + ps;
#pragma unroll
    for (int mt = 0; mt < DV / 16; ++mt) o[mt] *= alpha;
    pv_tile<DV, VLD>(Vs, s, o, li, lg);
}
__device__ __forceinline__ float lsum4(float l) { l += __shfl_xor(l, 16); l += __shfl_xor(l, 32); return l; }

struct Ctx { const Params* p; unsigned char* ws; LAS unsigned char* lds; int tid, lane, wv; };

__device__ __forceinline__ int queue_pop(int tidv, LAS unsigned char* lds, unsigned* ctr) {
    LAS int* s_item = (LAS int*)(lds + LDS_MISC);
    __syncthreads();
    if (tidv == 0) *s_item = (int)atomicAdd(ctr, 1u);
    __syncthreads();
    return *s_item;
}

__device__ void phase_w_a(int tidv, int bidv, KP P, int L, LAS unsigned char* lds) {
    unsigned char* ws = P->ws; const int tid = tidv;
    LAS float* tile = (LAS float*)lds;
    if (L == 0) {
        if (bidv == 0 && tid < 64) ((unsigned*)(ws + PS_CTR))[tid] = 0u;
        float2* rope = (float2*)(ws + PS_ROPE);
        for (int idx = bidv * 512 + tid; idx < S_ * 32; idx += gridDim.x * 512) { const int s = idx >> 5, i = idx & 31;
            double rv = (double)s * kInvFreqRev[i]; rv -= (double)(long long)rv; const float rf = (float)rv; rope[idx] = make_float2(__builtin_amdgcn_cosf(rf), __builtin_amdgcn_sinf(rf)); }
    }
    if (L == 0) rms_rows(tidv, bidv, P->in[0], P->in[2], (bf16_t*)(ws + OFF_H), P->X); else rms_rows(tidv, bidv, P->X, P->in[2] + 2048, (bf16_t*)(ws + OFF_H), nullptr);
    if (bidv == gridDim.x - 1) { const int sub = tid >> 8, j = tid & 255; const float* w1 = (sub ? P->in[20] : P->in[18]) + (size_t)L * 2048 * 256; const float* pos = P->in[17] + L * 2048;
        float a = 0.f; for (int k = 0; k < 2048; ++k) a += pos[k] * w1[k * 256 + j]; ((float*)(ws + PS_C1))[tid] = a; }
    if (bidv == gridDim.x - 2) for (int i = tid; i < 1024; i += 512) ((float*)(ws + PS_SPL))[i] = -8.0f * softplus_(-P->in[28][L * 1024 + i]);
    { bf16_t* rg = (bf16_t*)(ws + W_RG); const float* wr_ = P->in[24] + (size_t)L * 16 * 4096; const float* wi_ = P->in[26] + (size_t)L * 16 * 4096;
      for (int idx = bidv * 512 + tid; idx < 2048 * 256; idx += gridDim.x * 512) { const int j = idx >> 8, k = idx & 255, pn = j >> 8, c = j & 255, gate = c >> 7, ch = pn * 128 + (c & 127), hb = ch >> 6, o = ch & 63;
          const int ic = 256 * (pn >> 1) + k; float v = 0.f; if ((ic >> 6) == hb) v = (gate ? wi_ : wr_)[(size_t)hb * 4096 + (ic & 63) * 64 + o]; rg[idx] = f2bf(v); } }
    { const float* w = P->in[5] + (size_t)L * 2048 * 10304; convT(tidv, bidv, [=](int j) { return j < 10304 ? w + j : (const float*)nullptr; }, 2048, 10304, (bf16_t*)(ws + W_IN), 10496, tile); }
    { const float* w = P->in[29] + (size_t)L * 4 * 2048 * 2048; convT(tidv, bidv, [=](int j) { const int pn = j >> 8, c = j & 255, bj = c >> 7, wc = (c >> 5) & 3, n = (c >> 4) & 1, fq = (c >> 2) & 3, e = c & 3;
            return w + (size_t)(2 * bj + n) * 2048 * 2048 + (pn * 64 + wc * 16 + fq * 4 + e); }, 2048, 2048, (bf16_t*)(ws + W_G), 8192, tile); }
    { const float* w = P->in[30] + (size_t)L * 4 * 1024 * 2048; convT(tidv, bidv, [=](int j) { return w + (size_t)(j >> 11) * 1024 * 2048 + (j & 2047); }, 1024, 2048, (bf16_t*)(ws + W_B), 8192, tile); }
    { const float* w = P->in[31] + (size_t)L * 2048 * 2048; convT(tidv, bidv, [=](int j) { return w + j; }, 2048, 2048, (bf16_t*)(ws + W_OUT), 2048, tile); }
    { const float* wk = P->in[18] + (size_t)L * 2048 * 256; const float* wv_ = P->in[20] + (size_t)L * 2048 * 256; convT(tidv, bidv, [=](int j) { return j < 256 ? wk + j : wv_ + (j - 256); }, 2048, 256, (bf16_t*)(ws + W_C1), 512, tile); }
}
__device__ void phase_w_b(int tidv, int bidv, KP P, int L, LAS unsigned char* lds) {
    unsigned char* ws = P->ws; LAS float* tile = (LAS float*)lds;
    { const float* w = P->in[32] + (size_t)L * 2048 * 12288; convT(tidv, bidv, [=](int j) { return w + j; }, 2048, 12288, (bf16_t*)(ws + W_UP), 12288, tile); }
    { const float* w = P->in[35] + (size_t)L * 6144 * 2048; convT(tidv, bidv, [=](int j) { return w + j; }, 6144, 2048, (bf16_t*)(ws + W_DN), 2048, tile); }
    { const float* w = P->in[37] + (size_t)L * 2048 * 2048; convT(tidv, bidv, [=](int j) { return w + j; }, 2048, 2048, (bf16_t*)(ws + W_PG), 2048, tile); }
    { const float* w = P->in[36] + (size_t)L * 256 * 2048; convT(tidv, bidv, [=](int j) { return w + j; }, 256, 2048, (bf16_t*)(ws + W_PP), 2048, tile); }
    { const float* src = P->in[1] + (size_t)L * T_ * 256; bf16_t* dst = (bf16_t*)(ws + W_PB);
      for (size_t i = (size_t)bidv * 512 + tidv; i < (size_t)T_ * 256 / 4; i += (size_t)gridDim.x * 512) { const f32x4 v = *(const f32x4*)(src + i * 4); u32x2 w; w.x = pk2(v[0], v[1]); w.y = pk2(v[2], v[3]); *(u32x2*)(dst + i * 4) = w; } }
}
__device__ void phase_prep(int tidv, int bidv, KP P, int L) {
    unsigned char* ws = P->ws; const int tid = tidv;
    bf16_t* PROJ = (bf16_t*)(ws + OFF_BIG); const float2* rope = (const float2*)(ws + PS_ROPE);
    bf16_t* KC = (bf16_t*)(ws + T_KCVC); bf16_t* VC = KC + (size_t)32 * 2048 * 64;
    bf16_t* XBC = (bf16_t*)(ws + T_XBC); bf16_t* XC = (bf16_t*)(ws + T_XC); float* DT = (float*)(ws + T_DT);
    const float* scw = P->in[6] + L * 4 * 1536; const float* scb = P->in[7] + L * 1536; const float* dtb = P->in[8] + L * 16;
    const float* rcw = P->in[22] + L * 4 * 1024; const float* rcb = P->in[23] + L * 1024;
    for (int t = bidv; t < T_; t += gridDim.x) {
        const int s = t & 2047, b = t >> 11; bf16_t* prow = PROJ + (size_t)t * LDP;
        for (int i = tid; i < 1920; i += 512) { const int vec = i >> 5, d = i & 31; int cb; float sc = 1.f;
            if (vec < 16) { cb = B_Q + 64 * vec; sc = 0.125f; } else if (vec < 32) cb = B_K + 64 * (vec - 16); else if (vec < 48) { cb = C_Q + 64 * (vec - 32); sc = 0.125f; }
            else if (vec < 52) cb = C_KS + 64 * (vec - 48); else if (vec < 56) cb = C_KW + 64 * (vec - 52); else cb = C_KC + 64 * (vec - 56);
            const float x1 = bf2f(prow[cb + d]), x2 = bf2f(prow[cb + d + 32]); const float2 cs = rope[s * 32 + d];
            const float o1 = (x1 * cs.x - x2 * cs.y) * sc, o2 = (x2 * cs.x + x1 * cs.y) * sc;
            if (vec < 56) { prow[cb + d] = f2bf(o1); prow[cb + d + 32] = f2bf(o2); }
            else { bf16_t* kd = KC + ((size_t)(b * 4 + (vec - 56)) * 2048 + s) * 64; kd[d] = f2bf(o1); kd[d + 32] = f2bf(o2); } }
        if (tid < 256) { const int g = tid >> 6, d = tid & 63; VC[((size_t)(b * 4 + g) * 2048 + s) * 64 + d] = prow[C_VC + tid]; }
        for (int c = tid; c < 1536; c += 512) { float a = scb[c];
#pragma unroll
            for (int k = 0; k < 4; ++k) if (s - 3 + k >= 0) a += scw[k * 1536 + c] * bf2f(PROJ[(size_t)(t - 3 + k) * LDP + A_XBC + c]);
            XBC[(size_t)t * 1536 + c] = f2bf(silu_(a)); }
        if (tid < 16) DT[t * 16 + tid] = softplus_(bf2f(prow[A_DT + tid]) + dtb[tid]);
        for (int c = tid; c < 1024; c += 512) { float a = rcb[c];
#pragma unroll
            for (int k = 0; k < 4; ++k) if (s - 3 + k >= 0) a += rcw[k * 1024 + c] * bf2f(PROJ[(size_t)(t - 3 + k) * LDP + D_X + c]);
            XC[(size_t)t * 1024 + c] = f2bf(a); }
    }
}

__device__ void item_ssd(int tidv, KP P, int L, LAS unsigned char* lds, int b, int h) {
    unsigned char* ws = P->ws; const int tid = tidv;
    const bf16_t* XBC = (const bf16_t*)(ws + T_XBC); const float* DT = (const float*)(ws + T_DT); bf16_t* O0 = (bf16_t*)(ws + O_O);
    LAS float* xs = (LAS float*)lds; LAS float* Bm = xs + 4096; LAS float* Cm = Bm + 8192; LAS float* dtv = Cm + 8192; LAS float* dec = dtv + 64; LAS float* yb = dec + 64;
    const float Aneg = -__expf(P->in[9][L * 16 + h]), Dh = P->in[10][L * 16 + h];
    const int gi = h >> 3, p = tid >> 3, nq = tid & 7, n0 = nq * 16;
    float hst[16];
#pragma unroll
    for (int k = 0; k < 16; ++k) hst[k] = 0.f;
    for (int ch = 0; ch < 32; ++ch) {
        const int t0 = b * 2048 + ch * 64;
#pragma unroll
        for (int k = 0; k < 8; ++k) { const int idx = tid + 512 * k, st = idx >> 6, pp = idx & 63; xs[idx] = bf2f(XBC[(size_t)(t0 + st) * 1536 + h * 64 + pp]); }
#pragma unroll
        for (int k = 0; k < 16; ++k) { const int idx = tid + 512 * k, st = idx >> 7, n = idx & 127; const bf16_t* r = XBC + (size_t)(t0 + st) * 1536 + 1024 + gi * 128 + n; Bm[idx] = bf2f(r[0]); Cm[idx] = bf2f(r[256]); }
        if (tid < 64) { const float d = DT[(t0 + tid) * 16 + h]; dtv[tid] = d; dec[tid] = __expf(d * Aneg); }
        __syncthreads();
        for (int i = 0; i < 64; ++i) {
            const float dc = dec[i], xv = xs[i * 64 + p], cf = dtv[i] * xv; float part = 0.f;
#pragma unroll
            for (int k4 = 0; k4 < 4; ++k4) { const f32x4 bv = *(const LAS f32x4*)(Bm + i * 128 + n0 + k4 * 4), cv = *(const LAS f32x4*)(Cm + i * 128 + n0 + k4 * 4);
#pragma unroll
                for (int e = 0; e < 4; ++e) { hst[k4 * 4 + e] = dc * hst[k4 * 4 + e] + cf * bv[e]; part += hst[k4 * 4 + e] * cv[e]; } }
            part += __shfl_xor(part, 1); part += __shfl_xor(part, 2); part += __shfl_xor(part, 4);
            if (nq == 0) yb[i * 64 + p] = part + Dh * xv;
        }
        __syncthreads();
#pragma unroll
        for (int k = 0; k < 8; ++k) { const int idx = tid + 512 * k, st = idx >> 6, pp = idx & 63; O0[(size_t)(t0 + st) * 1024 + h * 64 + pp] = f2bf(yb[idx]); }
    }
}
__device__ void item_rgscan(int tidv, KP P, LAS unsigned char* lds, int b, int hb) {
    unsigned char* ws = P->ws; const int lane = tidv & 63, w = tidv >> 6;
    const bf16_t* LA = (const bf16_t*)(ws + T_LA); const bf16_t* UU = (const bf16_t*)(ws + T_UU); const bf16_t* PROJ = (const bf16_t*)(ws + OFF_BIG); bf16_t* O3 = (bf16_t*)(ws + O_O) + (size_t)3 * T_ * 1024;
    LAS float* sA = (LAS float*)lds; LAS float* sH = sA + 512;
    const int ch = hb * 64 + lane; const size_t r0 = (size_t)b * 2048 + w * 256;
    float A = 1.f, hh = 0.f;
#pragma unroll 8
    for (int t = 0; t < 256; ++t) { const float a = __expf(bf2f(LA[(r0 + t) * 1024 + ch])), u = bf2f(UU[(r0 + t) * 1024 + ch]); hh = a * hh + u; A *= a; }
    sA[w * 64 + lane] = A; sH[w * 64 + lane] = hh;
    __syncthreads();
    float hc = 0.f; for (int c = 0; c < w; ++c) hc = sA[c * 64 + lane] * hc + sH[c * 64 + lane];
#pragma unroll 8
    for (int t = 0; t < 256; ++t) { const float a = __expf(bf2f(LA[(r0 + t) * 1024 + ch])), u = bf2f(UU[(r0 + t) * 1024 + ch]); hc = a * hc + u;
        const float gt = bf2f(PROJ[(r0 + t) * LDP + D_GATE + ch]); O3[(r0 + t) * 1024 + ch] = f2bf(hc * gelu_t(gt)); }
}
__device__ void item_cmp2(int tidv, KP P, int L, int it) {
    unsigned char* ws = P->ws; const int tid = tidv; const bf16_t* HID = (const bf16_t*)(ws + T_HID); bf16_t* dst = (bf16_t*)(ws + T_KC2);
    const int r0 = it * 64, sub = r0 >= 4096; const float* w2 = (sub ? P->in[21] : P->in[19]) + (size_t)L * 256 * 64;
    const int d = tid & 63, rr = tid >> 6; float acc[8];
#pragma unroll
    for (int q = 0; q < 8; ++q) acc[q] = 0.f;
    for (int j = 0; j < 256; ++j) { const float w = w2[j * 64 + d];
#pragma unroll
        for (int q = 0; q < 8; ++q) acc[q] += bf2f(HID[(size_t)(r0 + rr * 8 + q) * 256 + j]) * w; }
#pragma unroll
    for (int q = 0; q < 8; ++q) dst[(size_t)(r0 + rr * 8 + q) * 64 + d] = f2bf(acc[q]);
}
__device__ void item_diff(int tidv, KP P, int L, LAS unsigned char* lds, int b, int h, int qb) {
    unsigned char* ws = P->ws; const int tid = tidv, lane = tid & 63, w = tid >> 6, li = lane & 15, lg = lane >> 4;
    const bf16_t* PROJ = (const bf16_t*)(ws + OFF_BIG); bf16_t* O1 = (bf16_t*)(ws + O_O) + (size_t)1 * T_ * 1024;
    LAS bf16_t* Ks = (LAS bf16_t*)lds; LAS bf16_t* Vs = Ks + 2 * 64 * 72; LAS float* ob = (LAS float*)(lds + 40960);
    const int mp = w >> 2, qs = w & 3, qpos = qb * 64 + qs * 16 + li; const size_t trow = (size_t)b * 2048 + qpos;
    bf16x8 qf[2];
#pragma unroll
    for (int ks = 0; ks < 2; ++ks) qf[ks] = *(const bf16x8*)(PROJ + trow * LDP + B_Q + h * 128 + mp * 64 + ks * 32 + lg * 8);
    f32x4 o[8];
#pragma unroll
    for (int i = 0; i < 8; ++i) o[i] = (f32x4){0.f, 0.f, 0.f, 0.f};
    float m = -1e30f, l = 0.f;
    for (int kt = 0; kt <= qb; ++kt) {
        const bf16_t* kb = PROJ + ((size_t)b * 2048 + kt * 64) * LDP;
        __syncthreads();
        stage_rows(tidv, Ks, 72, kb + B_K + h * 128, LDP, 64, 64); stage_rows(tidv, Ks + 64 * 72, 72, kb + B_K + h * 128 + 64, LDP, 64, 64); stage_rows(tidv, Vs, 136, kb + B_V + h * 128, LDP, 64, 128);
        __syncthreads();
        const int k0 = kt * 64;
        attn_tile<128, 136>(Ks + mp * 64 * 72, Vs, qf, o, m, l, li, lg, [=](int ko) { return k0 + ko <= qpos; });
    }
    l = lsum4(l); const float inv = 1.f / fmaxf(l, 1e-30f);
#pragma unroll
    for (int i = 0; i < 8; ++i) o[i] *= inv;
    __syncthreads();
    if (mp == 1) {
#pragma unroll
        for (int mt = 0; mt < 8; ++mt) *(LAS f32x4*)(ob + (qs * 16 + li) * 132 + mt * 16 + lg * 4) = o[mt];
    }
    __syncthreads();
    if (mp == 0) {
        float d1 = 0.f, d2 = 0.f; for (int i = 0; i < 64; ++i) { d1 += P->in[12][L * 64 + i] * P->in[13][L * 64 + i]; d2 += P->in[14][L * 64 + i] * P->in[15][L * 64 + i]; }
        const float linit = L == 0 ? 0.2f : 0.35550906759f; const float lam = __expf(d1) - __expf(d2) + linit;
        float ss = 0.f;
#pragma unroll
        for (int mt = 0; mt < 8; ++mt) { const f32x4 o2 = *(const LAS f32x4*)(ob + (qs * 16 + li) * 132 + mt * 16 + lg * 4); o[mt] -= lam * o2; ss += o[mt][0] * o[mt][0] + o[mt][1] * o[mt][1] + o[mt][2] * o[mt][2] + o[mt][3] * o[mt][3]; }
        ss = lsum4(ss); const float rs = rsqrtf(ss * (1.f / 128.f) + 1e-6f) * (1.f - linit);
        const float* gn = P->in[16] + L * 128;
#pragma unroll
        for (int mt = 0; mt < 8; ++mt) { const f32x4 gg = *(const f32x4*)(gn + mt * 16 + lg * 4); u32x2 wv; wv.x = pk2(o[mt][0] * rs * gg[0], o[mt][1] * rs * gg[1]); wv.y = pk2(o[mt][2] * rs * gg[2], o[mt][3] * rs * gg[3]);
            *(u32x2*)(O1 + trow * 1024 + h * 128 + mt * 16 + lg * 4) = wv; }
    }
}
template <int MODE>
__device__ void item_nsa(int tidv, KP P, LAS unsigned char* lds, int bg, int pb) {
    unsigned char* ws = P->ws; const int tid = tidv, lane = tid & 63, w = tid >> 6, li = lane & 15, lg = lane >> 4;
    const bf16_t* PROJ = (const bf16_t*)(ws + OFF_BIG); bf16_t* O2 = (bf16_t*)(ws + O_O) + (size_t)2 * T_ * 1024; const unsigned* SELM = (const unsigned*)(ws + PS_SELM);
    LAS bf16_t* Ks = (LAS bf16_t*)lds; LAS bf16_t* Vs = Ks + 64 * 72;
    const int b = bg >> 2, g = bg & 3, j = w >> 1, hd = g * 4 + j, p0 = pb * 32, qpos = p0 + (w & 1) * 16 + li; const size_t trow = (size_t)b * 2048 + qpos;
    bf16x8 qf[2];
#pragma unroll
    for (int ks = 0; ks < 2; ++ks) qf[ks] = *(const bf16x8*)(PROJ + trow * LDP + C_Q + hd * 64 + ks * 32 + lg * 8);
    f32x4 o[4];
#pragma unroll
    for (int i = 0; i < 4; ++i) o[i] = (f32x4){0.f, 0.f, 0.f, 0.f};
    float m = -1e30f, l = 0.f;
    unsigned selm = 0, um = 0;
    int tlo = 0; const int thi = (p0 + 31) >> 6;
    if (MODE == 0) { tlo = (p0 - 511) > 0 ? ((p0 - 511) >> 6) : 0; }
    else { selm = SELM[bg * 2048 + qpos]; for (int i = 0; i < 32; ++i) um |= SELM[bg * 2048 + p0 + i]; }
    const int kcol = (MODE == 0 ? C_KW : C_KS) + g * 64, vcol = (MODE == 0 ? C_VW : C_VS) + g * 64;
    for (int kt = tlo; kt <= thi; ++kt) {
        if (MODE == 1 && !((um >> kt) & 1u)) continue;
        const bf16_t* kb = PROJ + ((size_t)b * 2048 + kt * 64) * LDP;
        __syncthreads();
        stage_rows(tidv, Ks, 72, kb + kcol, LDP, 64, 64); stage_rows(tidv, Vs, 72, kb + vcol, LDP, 64, 64);
        __syncthreads();
        const int k0 = kt * 64;
        if (MODE == 0) attn_tile<64, 72>(Ks, Vs, qf, o, m, l, li, lg, [=](int ko) { const int kp = k0 + ko; return kp <= qpos && kp > qpos - 512; });
        else { const bool sel = (selm >> kt) & 1u; attn_tile<64, 72>(Ks, Vs, qf, o, m, l, li, lg, [=](int ko) { return sel && (k0 + ko <= qpos); }); }
    }
    l = lsum4(l); const float gate = sigm(bf2f(PROJ[trow * LDP + C_G + hd * 3 + (MODE == 0 ? 2 : 1)])); const float inv = gate / fmaxf(l, 1e-30f);
#pragma unroll
    for (int mt = 0; mt < 4; ++mt) { bf16_t* op = O2 + trow * 1024 + hd * 64 + mt * 16 + lg * 4; f32x4 v = o[mt] * inv;
        if (MODE == 1) { const u32x2 pv = *(const u32x2*)op; v[0] += bf2f((bf16_t)(pv.x & 0xffff)); v[1] += bf2f((bf16_t)(pv.x >> 16)); v[2] += bf2f((bf16_t)(pv.y & 0xffff)); v[3] += bf2f((bf16_t)(pv.y >> 16)); }
        u32x2 wv; wv.x = pk2(v[0], v[1]); wv.y = pk2(v[2], v[3]); *(u32x2*)op = wv; }
}
__device__ void item_cmp(int tidv, KP P, LAS unsigned char* lds, int bg, int pb) {
    unsigned char* ws = P->ws; const int tid = tidv, lane = tid & 63, w = tid >> 6, li = lane & 15, lg = lane >> 4;
    const bf16_t* PROJ = (const bf16_t*)(ws + OFF_BIG); bf16_t* O2 = (bf16_t*)(ws + O_O) + (size_t)2 * T_ * 1024; unsigned* SELM = (unsigned*)(ws + PS_SELM);
    const bf16_t* KC2 = (const bf16_t*)(ws + T_KC2) + (size_t)bg * 128 * 64; const bf16_t* VC2 = (const bf16_t*)(ws + T_VC2) + (size_t)bg * 128 * 64;
    LAS bf16_t* Ks = (LAS bf16_t*)lds; LAS bf16_t* Vs = Ks + 128 * 72;
    LAS float* impA = (LAS float*)(lds + 40960); LAS float* impB = impA + 4 * 32 * 33; LAS float* impF = impB + 4 * 32 * 33; LAS unsigned* selb = (LAS unsigned*)(impF + 32 * 33);
    const int b = bg >> 2, g = bg & 3, j = w >> 1, hd = g * 4 + j, p0 = pb * 32, pl = (w & 1) * 16 + li, qpos = p0 + pl; const size_t trow = (size_t)b * 2048 + qpos;
    bf16x8 qf[2];
#pragma unroll
    for (int ks = 0; ks < 2; ++ks) qf[ks] = *(const bf16x8*)(PROJ + trow * LDP + C_Q + hd * 64 + ks * 32 + lg * 8);
    __syncthreads();
    stage_rows(tidv, Ks, 72, KC2, 64, 128, 64); stage_rows(tidv, Vs, 72, VC2, 64, 128, 64);
    __syncthreads();
    f32x4 s0[4], s1[4]; qk_tile(Ks, qf, s0, li, lg); qk_tile(Ks + 64 * 72, qf, s1, li, lg);
    float mx = -1e30f;
#pragma unroll
    for (int kt = 0; kt < 4; ++kt)
#pragma unroll
        for (int jj = 0; jj < 4; ++jj) { const int n0 = kt * 16 + lg * 4 + jj, n1 = 64 + n0;
            const float a = (16 * n0 + 31 <= qpos) ? s0[kt][jj] * LOG2E : -1e30f, c = (16 * n1 + 31 <= qpos) ? s1[kt][jj] * LOG2E : -1e30f; s0[kt][jj] = a; s1[kt][jj] = c; mx = fmaxf(mx, fmaxf(a, c)); }
    mx = fmaxf(mx, __shfl_xor(mx, 16)); mx = fmaxf(mx, __shfl_xor(mx, 32));
    float ps = 0.f;
#pragma unroll
    for (int kt = 0; kt < 4; ++kt)
#pragma unroll
        for (int jj = 0; jj < 4; ++jj) { const float a = s0[kt][jj] > -1e29f ? __builtin_amdgcn_exp2f(s0[kt][jj] - mx) : 0.f, c = s1[kt][jj] > -1e29f ? __builtin_amdgcn_exp2f(s1[kt][jj] - mx) : 0.f; s0[kt][jj] = a; s1[kt][jj] = c; ps += a + c; }
    ps = lsum4(ps); const float inv = 1.f / fmaxf(ps, 1e-30f);
#pragma unroll
    for (int kt = 0; kt < 4; ++kt) { s0[kt] *= inv; s1[kt] *= inv; }
    f32x4 o[4];
#pragma unroll
    for (int i = 0; i < 4; ++i) o[i] = (f32x4){0.f, 0.f, 0.f, 0.f};
    pv_tile<64, 72>(Vs, s0, o, li, lg); pv_tile<64, 72>(Vs + 64 * 72, s1, o, li, lg);
    { LAS float* ia = impA + (j * 32 + pl) * 33; LAS float* ib = impB + (j * 32 + pl) * 33;
#pragma unroll
      for (int kt = 0; kt < 4; ++kt) { const int m0 = kt * 4 + lg, m1 = 16 + m0;
          ia[m0] = s0[kt][0] + s0[kt][1] + s0[kt][2] + 0.5f * s0[kt][3]; ib[m0 + 1] = 0.5f * s0[kt][3];
          ia[m1] = s1[kt][0] + s1[kt][1] + s1[kt][2] + 0.5f * s1[kt][3]; ib[m1 + 1] = 0.5f * s1[kt][3]; }
      if (lg == 0) ib[0] = 0.f; }
    __syncthreads();
#pragma unroll
    for (int k = 0; k < 2; ++k) { const int idx = tid + 512 * k, pos = idx >> 5, mm = idx & 31; float v = 0.f;
#pragma unroll
        for (int jj = 0; jj < 4; ++jj) v += impA[(jj * 32 + pos) * 33 + mm] + impB[(jj * 32 + pos) * 33 + mm];
        const int cur = (p0 + pos) >> 6; if (mm == 0 || mm == cur) v = 1e4f; else if (mm > cur) v = -1e30f; impF[pos * 33 + mm] = v; }
    if (tid < 32) selb[tid] = 0u;
    __syncthreads();
    { const int pos = tid >> 4; unsigned bits = 0;
#pragma unroll
      for (int k = 0; k < 2; ++k) { const int mm = (tid & 15) * 2 + k; const float v = impF[pos * 33 + mm]; int cnt = 0;
          for (int m2 = 0; m2 < 32; ++m2) { const float v2 = impF[pos * 33 + m2]; cnt += (v2 > v || (v2 == v && m2 < mm)) ? 1 : 0; }
          if (cnt < 8) bits |= 1u << mm; }
      if (bits) atomicOr((unsigned*)(selb + pos), bits); }
    __syncthreads();
    if (tid < 32) SELM[bg * 2048 + p0 + tid] = selb[tid];
    const float gate = sigm(bf2f(PROJ[trow * LDP + C_G + hd * 3 + 0]));
#pragma unroll
    for (int mt = 0; mt < 4; ++mt) { bf16_t* op = O2 + trow * 1024 + hd * 64 + mt * 16 + lg * 4; f32x4 v = o[mt] * gate; const u32x2 pv = *(const u32x2*)op;
        v[0] += bf2f((bf16_t)(pv.x & 0xffff)); v[1] += bf2f((bf16_t)(pv.x >> 16)); v[2] += bf2f((bf16_t)(pv.y & 0xffff)); v[3] += bf2f((bf16_t)(pv.y >> 16));
        u32x2 wv; wv.x = pk2(v[0], v[1]); wv.y = pk2(v[2], v[3]); *(u32x2*)op = wv; }
}
__device__ void ssd_finalize(int tidv, int bidv, KP P, int L) {
    unsigned char* ws = P->ws; const int lane = tidv & 63, wv = tidv >> 6; bf16_t* O0 = (bf16_t*)(ws + O_O); const bf16_t* PROJ = (const bf16_t*)(ws + OFF_BIG); const float* gn = P->in[11] + L * 1024;
    for (int row = bidv * 8 + wv; row < T_; row += gridDim.x * 8) {
        float v[16]; float ss = 0.f;
#pragma unroll
        for (int i = 0; i < 4; ++i) { const int c = i * 256 + lane * 4; const u32x2 yv = *(const u32x2*)(O0 + (size_t)row * 1024 + c), zv = *(const u32x2*)(PROJ + (size_t)row * LDP + A_Z + c);
            const float y[4] = {bf2f((bf16_t)(yv.x & 0xffff)), bf2f((bf16_t)(yv.x >> 16)), bf2f((bf16_t)(yv.y & 0xffff)), bf2f((bf16_t)(yv.y >> 16))};
            const float z[4] = {bf2f((bf16_t)(zv.x & 0xffff)), bf2f((bf16_t)(zv.x >> 16)), bf2f((bf16_t)(zv.y & 0xffff)), bf2f((bf16_t)(zv.y >> 16))};
#pragma unroll
            for (int e = 0; e < 4; ++e) { const float t = y[e] * silu_(z[e]); v[i * 4 + e] = t; ss += t * t; } }
#pragma unroll
        for (int o = 32; o >= 1; o >>= 1) ss += __shfl_xor(ss, o);
        const float rs = rsqrtf(ss * (1.f / 1024.f) + 1e-6f);
#pragma unroll
        for (int i = 0; i < 4; ++i) { const int c = i * 256 + lane * 4; const f32x4 gg = *(const f32x4*)(gn + c); u32x2 w; w.x = pk2(v[i * 4] * rs * gg[0], v[i * 4 + 1] * rs * gg[1]); w.y = pk2(v[i * 4 + 2] * rs * gg[2], v[i * 4 + 3] * rs * gg[3]);
            *(u32x2*)(O0 + (size_t)row * 1024 + c) = w; }
    }
}
__device__ void phase_ffn_act(int tidv, int bidv, KP P, int L) {
    unsigned char* ws = P->ws; const bf16_t* U = (const bf16_t*)(ws + OFF_BIG); bf16_t* ACT = (bf16_t*)(ws + O_ACT);
    const float* cw = P->in[33] + (size_t)L * 3 * 12288; const float* cb = P->in[34] + (size_t)L * 12288;
    for (size_t it = (size_t)bidv * 512 + tidv; it < (size_t)T_ * 768; it += (size_t)gridDim.x * 512) {
        const int t = (int)(it / 768), c = (int)(it % 768) * 8, s = t & 2047;
        float ug[8], uv[8];
#pragma unroll
        for (int e = 0; e < 8; ++e) { ug[e] = cb[c + e]; uv[e] = cb[6144 + c + e]; }
#pragma unroll
        for (int k = 0; k < 3; ++k) if (s - 2 + k >= 0) { const bf16x8 a = *(const bf16x8*)(U + (size_t)(t - 2 + k) * 12288 + c), d = *(const bf16x8*)(U + (size_t)(t - 2 + k) * 12288 + 6144 + c);
#pragma unroll
            for (int e = 0; e < 8; ++e) { ug[e] += cw[k * 12288 + c + e] * bf2f((bf16_t)a[e]); uv[e] += cw[k * 12288 + 6144 + c + e] * bf2f((bf16_t)d[e]); } }
        u32x4 w; w.x = pk2(gelu_t(ug[0]) * uv[0], gelu_t(ug[1]) * uv[1]); w.y = pk2(gelu_t(ug[2]) * uv[2], gelu_t(ug[3]) * uv[3]); w.z = pk2(gelu_t(ug[4]) * uv[4], gelu_t(ug[5]) * uv[5]); w.w = pk2(gelu_t(ug[6]) * uv[6], gelu_t(ug[7]) * uv[7]);
        *(u32x4*)(ACT + (size_t)t * 6144 + c) = w;
    }
}
__device__ void final_norm(int tidv, int bidv, KP P) {
    const int lane = tidv & 63, wv = tidv >> 6; const float* g = P->in[38];
    for (int row = bidv * 8 + wv; row < T_; row += gridDim.x * 8) {
        float* xr = P->X + (size_t)row * 2048; f32x4 v[8]; float ss = 0.f;
#pragma unroll
        for (int i = 0; i < 8; ++i) { v[i] = *(const f32x4*)(xr + i * 256 + lane * 4); ss += v[i][0] * v[i][0] + v[i][1] * v[i][1] + v[i][2] * v[i][2] + v[i][3] * v[i][3]; }
#pragma unroll
        for (int o = 32; o >= 1; o >>= 1) ss += __shfl_xor(ss, o);
        const float rs = rsqrtf(ss * (1.0f / 2048.0f) + 1e-6f);
#pragma unroll
        for (int i = 0; i < 8; ++i) { const f32x4 gg = *(const f32x4*)(g + i * 256 + lane * 4); *(f32x4*)(xr + i * 256 + lane * 4) = v[i] * rs * gg; }
    }
}

#ifdef ONLY_CASE
#define CASE_ON(n) (ONLY_CASE == n)
#else
#define CASE_ON(n) 1
#endif
constexpr int PH_PER_LAYER = 16, N_PHASES = 2 * PH_PER_LAYER + 1;

__device__ void run_phase(int tidv, int bidv, KP P, int ph, LAS unsigned char* lds) {
    unsigned char* ws = P->ws;
    if (ph == 2 * PH_PER_LAYER) { final_norm(tidv, bidv, P); return; }
    const int L = ph / PH_PER_LAYER, k = ph % PH_PER_LAYER; const int G = gridDim.x, c = bidv;
    unsigned* ctr = (unsigned*)(ws + PS_CTR) + L * 4;
    pg8::Order S;
    switch (k) {
#if CASE_ON(0)
    case 0: phase_w_a(tidv, bidv, P, L, lds); break;
#endif
#if CASE_ON(1)
    case 1: { S.init(64, 41, 1, G, c, 0); pg8::gemm_phase<2048, 2048>(tidv, bidv, lds, (const bf16_t*)(ws + OFF_H), (const bf16_t*)(ws + W_IN), S, EpiBf{(bf16_t*)(ws + OFF_BIG), LDP, 0x7fffffff, nullptr}); } break;
#endif
#if CASE_ON(2)
    case 2: phase_prep(tidv, bidv, P, L); break;
#endif
#if CASE_ON(3)
    case 3: {
        if (c >= 32) {
            S.init(64, 8, 1, G - 32, c - 32, 1);
            pg8::gemm_phase<1024, 256>(tidv, bidv, lds, (const bf16_t*)(ws + T_XC), (const bf16_t*)(ws + W_RG), S,
                            EpiRG{(const bf16_t*)(ws + T_XC), P->in[25] + L * 1024, P->in[27] + L * 1024, (const float*)(ws + PS_SPL), (bf16_t*)(ws + T_LA), (bf16_t*)(ws + T_UU)});
        } else {
            S.init(16, 1, 2, 32, c, 0);
            pg8::gemm_phase<1024, 2048>(tidv, bidv, lds, (const bf16_t*)(ws + T_KCVC), (const bf16_t*)(ws + W_C1), S, EpiHid{(bf16_t*)(ws + T_HID), 256, 0, (const float*)(ws + PS_C1)});
        }
    } break;
#endif
#if CASE_ON(4)
    case 4: {
        for (;;) { const int it = queue_pop(tidv, lds, ctr + 0); if (it >= 256 + 128 + 4096) break;
            if (it < 128) item_ssd(tidv, P, L, lds, it >> 4, it & 15);
            else if (it < 256) item_rgscan(tidv, P, lds, (it - 128) >> 4, (it - 128) & 15);
            else if (it < 384) item_cmp2(tidv, P, L, it - 256);
            else if (it < 384 + 2048) { const int jx = it - 384; item_diff(tidv, P, L, lds, (jx & 63) >> 3, jx & 7, 31 - (jx >> 6)); }
            else { const int jx = it - 384 - 2048; item_nsa<0>(tidv, P, lds, jx & 31, 63 - (jx >> 5)); } }
    } break;
#endif
#if CASE_ON(5)
    case 5: { ssd_finalize(tidv, bidv, P, L);
        for (;;) { const int it = queue_pop(tidv, lds, ctr + 1); if (it >= 2048) break; item_cmp(tidv, P, lds, it & 31, 63 - (it >> 5)); } } break;
#endif
#if CASE_ON(6)
    case 6: { for (;;) { const int it = queue_pop(tidv, lds, ctr + 2); if (it >= 2048) break; item_nsa<1>(tidv, P, lds, it & 31, 63 - (it >> 5)); } } break;
#endif
#if CASE_ON(7)
    case 7: { S.init(64, 8, 4, G, c, 0);
        pg8::gemm_phase<1024, 1024>(tidv, bidv, lds, (const bf16_t*)(ws + O_O), (const bf16_t*)(ws + W_B), S, EpiBf{(bf16_t*)(ws + OFF_BIG), 2048, 7, nullptr});
        phase_w_b(tidv, bidv, P, L, lds); } break;
#endif
#if CASE_ON(8)
    case 8: { S.init(64, 32, 1, G, c, 0); pg8::gemm_phase<2048, 2048>(tidv, bidv, lds, (const bf16_t*)(ws + OFF_H), (const bf16_t*)(ws + W_G), S, EpiMerge{(const bf16_t*)(ws + OFF_BIG), (bf16_t*)(ws + O_MERGED)}); } break;
#endif
#if CASE_ON(9)
    case 9: { S.init(64, 8, 1, G, c, 0); pg8::gemm_phase<2048, 2048>(tidv, bidv, lds, (const bf16_t*)(ws + O_MERGED), (const bf16_t*)(ws + W_OUT), S, EpiResid{P->X, nullptr}); } break;
#endif
#if CASE_ON(10)
    case 10: rms_rows(tidv, bidv, P->X, P->in[3] + L * 2048, (bf16_t*)(ws + OFF_H), nullptr); break;
#endif
#if CASE_ON(11)
    case 11: { S.init(64, 48, 1, G, c, 0); pg8::gemm_phase<2048, 2048>(tidv, bidv, lds, (const bf16_t*)(ws + OFF_H), (const bf16_t*)(ws + W_UP), S, EpiBf{(bf16_t*)(ws + OFF_BIG), 12288, 0x7fffffff, nullptr}); } break;
#endif
#if CASE_ON(12)
    case 12: phase_ffn_act(tidv, bidv, P, L); break;
#endif
#if CASE_ON(13)
    case 13: { S.init(64, 8, 1, G, c, 0); pg8::gemm_phase<6144, 6144>(tidv, bidv, lds, (const bf16_t*)(ws + O_ACT), (const bf16_t*)(ws + W_DN), S, EpiResid{P->X, nullptr}); } break;
#endif
#if CASE_ON(14)
    case 14: { rms_rows(tidv, bidv, P->X, P->in[4] + L * 2048, (bf16_t*)(ws + OFF_H), nullptr);
        asm volatile("" : "+v"(tidv)); asm volatile("" : "+s"(bidv));
        S.init(64, 8, 1, G, c, 0); pg8::gemm_phase<256, 256>(tidv, bidv, lds, (const bf16_t*)(ws + W_PB), (const bf16_t*)(ws + W_PP), S, EpiBf{(bf16_t*)(ws + O_PP), 2048, 0x7fffffff, nullptr}); } break;
#endif
#if CASE_ON(15)
    case 15: { S.init(64, 8, 1, G, c, 0); pg8::gemm_phase<2048, 2048>(tidv, bidv, lds, (const bf16_t*)(ws + OFF_H), (const bf16_t*)(ws + W_PG), S, EpiResid{P->X, (const bf16_t*)(ws + O_PP)}); } break;
#endif
    }
}

__global__ void __launch_bounds__(512, 2) hybrid_fwd(Params P, int ph_lo, int ph_hi) {
    extern __shared__ __attribute__((aligned(16))) unsigned char shm[];
    LAS unsigned char* lds = (LAS unsigned char*)shm;
    cg::grid_group grid = cg::this_grid();
    for (int ph = ph_lo; ph < ph_hi; ++ph) {
        if (ph > ph_lo) grid.sync();
        int tidv = threadIdx.x, bidv = blockIdx.x; asm volatile("" : "+v"(tidv)); asm volatile("" : "+s"(bidv));
        KP kp = (KP)__builtin_amdgcn_kernarg_segment_ptr(); asm volatile("" : "+s"(kp));
        run_phase(tidv, bidv, kp, ph, lds);
        __syncthreads();
    }
}

extern "C" void kernel_launch(void* const* d_in, const int* in_sizes, int n_in, void* d_out, int out_size, void* d_ws, size_t ws_size, hipStream_t stream) {
    static int grid = 0;
    if (grid == 0) {
        int dev = 0, cus = 0, per_cu = 0;
        hipGetDevice(&dev); hipDeviceGetAttribute(&cus, hipDeviceAttributeMultiprocessorCount, dev);
        if (hipFuncSetAttribute((const void*)hybrid_fwd, hipFuncAttributeMaxDynamicSharedMemorySize, LDS_BYTES) != hipSuccess) { fprintf(stderr, "hipFuncSetAttribute failed\n"); grid = -1; return; }
        hipOccupancyMaxActiveBlocksPerMultiprocessor(&per_cu, (const void*)hybrid_fwd, 512, LDS_BYTES);
        if (per_cu < 1) per_cu = 1;
        grid = cus * per_cu; if (grid > 256) grid = 256;
        if (n_in != 39 || ws_size < WS_END) { fprintf(stderr, "kernel_launch: unexpected n_in %d / ws_size %zu (need %zu)\n", n_in, ws_size, (size_t)WS_END); grid = -1; return; }
    }
    if (grid < 0) return;
    Params p{};
    for (int i = 0; i < 39; ++i) p.in[i] = (const float*)d_in[i];
    p.X = (float*)d_out; p.ws = (unsigned char*)d_ws;
#if ONE_LAUNCH
    int lo = 0, hi = N_PHASES;
    void* args[] = {&p, &lo, &hi};
    hipError_t e = hipLaunchCooperativeKernel((const void*)hybrid_fwd, dim3(grid), dim3(512), args, LDS_BYTES, stream);
    if (e != hipSuccess) fprintf(stderr, "cooperative launch failed: %s (grid %d)\n", hipGetErrorString(e), grid);
#else
    for (int ph = 0; ph < N_PHASES; ++ph) hipLaunchKernelGGL(hybrid_fwd, dim3(grid), dim3(512), LDS_BYTES, stream, p, ph, ph + 1);
#endif
}
```

```cpp
#include <hip/hip_runtime.h>
#include <hip/hip_cooperative_groups.h>
#include <cstdio>
namespace cg = cooperative_groups;

typedef unsigned short bf16_t;
typedef short bf16x8 __attribute__((ext_vector_type(8)));
typedef short s16x4 __attribute__((ext_vector_type(4)));
typedef float f32x4 __attribute__((ext_vector_type(4)));
typedef unsigned u32x4 __attribute__((ext_vector_type(4)));
typedef unsigned u32x2 __attribute__((ext_vector_type(2)));
#define LAS __attribute__((address_space(3)))

#ifndef PROBE_MASK
#define PROBE_MASK 0
#endif
#ifndef PROBE_ITEM
#define PROBE_ITEM 0
#endif
#ifndef ONE_LAUNCH
#define ONE_LAUNCH 1
#endif

constexpr int T_ = 16384, S_ = 2048, LDP = 10496;
constexpr int A_Z = 0, A_XBC = 1024, A_DT = 2560, B_Q = 2576, B_K = 3600, B_V = 4624, C_Q = 5648, C_KC = 6672, C_VC = 6928,
              C_KS = 7184, C_VS = 7440, C_KW = 7696, C_VW = 7952, C_G = 8208, D_GATE = 8256, D_X = 9280;
constexpr size_t MiB = 1u << 20;
constexpr size_t OFF_W = 0, OFF_H = 100 * MiB, OFF_O2 = 164 * MiB, OFF_BIG = 356 * MiB, OFF_TT = 684 * MiB, OFF_PS = 852 * MiB, WS_END = 853 * MiB;
constexpr size_t W_IN = OFF_W, W_G = W_IN + 41 * MiB, W_B = W_G + 32 * MiB, W_OUT = W_B + 16 * MiB, W_RG = W_OUT + 8 * MiB, W_C1 = W_RG + 1 * MiB;
constexpr size_t O_O = OFF_O2, O_MERGED = OFF_O2 + 128 * MiB, O_ACT = OFF_O2, O_PP = OFF_BIG + 32 * MiB;
constexpr size_t T_XBC = OFF_TT, T_XC = OFF_TT + 48 * MiB, T_KCVC = OFF_TT + 80 * MiB, T_LA = OFF_TT + 97 * MiB, T_UU = OFF_TT + 129 * MiB,
                 T_DT = OFF_TT + 161 * MiB, T_HID = OFF_TT + 162 * MiB, T_KC2 = OFF_TT + 166 * MiB, T_VC2 = T_KC2 + 512 * 1024, T_SSP = OFF_TT + 167 * MiB;
constexpr size_t W_UP = OFF_TT + 56 * MiB, W_DN = OFF_TT + 104 * MiB, W_PG = OFF_TT + 128 * MiB, W_PP = OFF_TT + 136 * MiB, W_PB = OFF_TT + 137 * MiB;
constexpr size_t PS_ROPE = OFF_PS, PS_SELM = OFF_PS + 512 * 1024, PS_C1 = OFF_PS + 768 * 1024, PS_CTR = OFF_PS + 800 * 1024, PS_SPL = OFF_PS + 804 * 1024, PS_BAR = OFF_PS + 816 * 1024, PS_LAM = OFF_PS + 812 * 1024;
constexpr int LDS_BYTES = 147456, LDS_MISC = 131072;

struct Params { const float* in[39]; float* X; unsigned char* ws; };
typedef const Params __attribute__((address_space(4)))* KP;

__device__ __forceinline__ float bf2f(bf16_t v) { return __uint_as_float(((unsigned)v) << 16); }
__device__ __forceinline__ bf16_t f2bf(float f) { unsigned u = __float_as_uint(f); u += 0x7FFFu + ((u >> 16) & 1u); return (bf16_t)(u >> 16); }
__device__ __forceinline__ unsigned pk2(float lo, float hi) { unsigned r; asm("v_cvt_pk_bf16_f32 %0, %1, %2" : "=v"(r) : "v"(lo), "v"(hi)); return r; }
__device__ __forceinline__ void unpack8(const u32x4 v, float (&f)[8]) {
    f[0] = bf2f((bf16_t)(v.x & 0xffff)); f[1] = bf2f((bf16_t)(v.x >> 16)); f[2] = bf2f((bf16_t)(v.y & 0xffff)); f[3] = bf2f((bf16_t)(v.y >> 16));
    f[4] = bf2f((bf16_t)(v.z & 0xffff)); f[5] = bf2f((bf16_t)(v.z >> 16)); f[6] = bf2f((bf16_t)(v.w & 0xffff)); f[7] = bf2f((bf16_t)(v.w >> 16)); }
__device__ __forceinline__ u32x4 pack8(const float (&f)[8]) { u32x4 w; w.x = pk2(f[0], f[1]); w.y = pk2(f[2], f[3]); w.z = pk2(f[4], f[5]); w.w = pk2(f[6], f[7]); return w; }
__device__ __forceinline__ float sigm(float x) { return __builtin_amdgcn_rcpf(1.f + __expf(-x)); }
__device__ __forceinline__ float gelu_t(float x) { float u = 1.5957691216f * (x + 0.044715f * x * x * x); return x * __builtin_amdgcn_rcpf(1.f + __expf(-u)); }
__device__ __forceinline__ float softplus_(float x) { return x > 20.f ? x : __logf(1.f + __expf(x)); }
__device__ __forceinline__ float silu_(float x) { return x * __builtin_amdgcn_rcpf(1.f + __expf(-x)); }

namespace pg8 {
constexpr int BM = 256, BK = 64, HALF = 128, HTB = HALF * BK * 2, NXCD = 8, WGM = 8;
__device__ __forceinline__ int lds_byte(int r, int c) { const int st = (r >> 4) * 2 + (c >> 5), rr = r & 15, cc = c & 31, ob = rr * 64 + cc * 2; return st * 1024 + (ob ^ (((ob >> 9) & 1) << 5)); }
__device__ __forceinline__ void stage_rc(int b, int& R, int& C) { const int st = b / 1024, sb = b % 1024, swz = sb ^ (((sb >> 9) & 1) << 5); R = (st >> 1) * 16 + swz / 64; C = (st & 1) * 32 + (swz % 64) / 2; }
__device__ __forceinline__ int perm32(int rho) { const int n = rho >> 4, i = rho & 15; return 8 * (i >> 2) + 4 * n + (i & 3); }
struct Unit { int pm, pn, ka; };
struct Gemm { const bf16_t* A; const bf16_t* Bt; int lda, K; };
struct Order {
    int nM, nN, nsub, G, c, kmode;
    __device__ void init(int nM_, int nN_, int nsub_, int G_, int c_, int kmode_) { nM = nM_; nN = nN_; nsub = nsub_; G = G_; c = c_; kmode = kmode_; }
    __device__ bool next(int i, Unit& u) const {
        const int nwg = nM * nN; const int L = i * G + c; if (L >= nwg * nsub) return false;
        const int sub = L / nwg; int wgid = L - sub * nwg;
        { const int q = nwg / NXCD, r = nwg % NXCD, xcd = wgid % NXCD, off = wgid / NXCD; wgid = (xcd < r ? xcd * (q + 1) : r * (q + 1) + (xcd - r) * q) + off; }
        const int nig = WGM * nN, gid = wgid / nig, fm = gid * WGM, gsz = (nM - fm) < WGM ? (nM - fm) : WGM;
        const int pm0 = fm + ((wgid % nig) % gsz), pn0 = (wgid % nig) / gsz;
        u.pm = __builtin_amdgcn_readfirstlane(sub * nM + pm0); u.pn = __builtin_amdgcn_readfirstlane(sub * nN + pn0); u.ka = __builtin_amdgcn_readfirstlane(kmode ? 256 * (pn0 >> 1) : 0); return true;
    }
};

template <int lda, int K, class Epi>
__device__ __forceinline__ void gemm_phase(int tidv, int bidv, LAS unsigned char* lds, const bf16_t* gA, const bf16_t* gBt, const Order& S, const Epi& E) {
    const int tid = tidv, wid = __builtin_amdgcn_readfirstlane(tid >> 6), lane = tid & 63, wr = wid >> 2, wc = wid & 3, fr = lane & 15, fq = lane >> 4;
    constexpr int nt = K / BK;
    unsigned voffA[2], voffB[2];
#pragma unroll
    for (int i = 0; i < 2; ++i) { int R, C; stage_rc(tid * 16 + i * 8192, R, C); const int Rb = Epi::PERM ? ((R & ~31) + perm32(R & 31)) : R;
        voffA[i] = (unsigned)(R * lda + C) * 2u; voffB[i] = (unsigned)(Rb * K + C) * 2u; }
    constexpr size_t kstep = (size_t)(BK * 2);
    constexpr size_t hstepA = (size_t)HALF * lda * 2, hstepB = (size_t)HALF * K * 2;
    constexpr size_t tstepA = 2 * hstepA, tstepB = 2 * hstepB;
    const unsigned ldsw = (unsigned)wid * 1024u;
    const int aoff = lds_byte(wr * 64 + fr, fq * 8), boff = lds_byte(wc * 32 + fr, fq * 8);
#define PG8_SA(b, h) (((b) * 2 + (h)) * HTB)
#define PG8_SB(b, h) ((4 + (b) * 2 + (h)) * HTB)
#define PG8_STAGE(bufoff, gbase, voff) do { _Pragma("unroll") for (int _i = 0; _i < 2; ++_i) \
        __builtin_amdgcn_global_load_lds((const unsigned*)((const char*)(gbase) + (voff)[_i]), (LAS unsigned*)(lds + (bufoff) + ldsw + _i * 8192), 16, 0, 0); } while (0)
#define PG8_LDA(dst, b, h) do { _Pragma("unroll") for (int m = 0; m < 4; ++m) _Pragma("unroll") for (int k = 0; k < 2; ++k) dst[m][k] = *(const LAS bf16x8*)(lds + PG8_SA(b, h) + aoff + m * 2048 + k * 1024); } while (0)
#define PG8_LDB(dst, b, h) do { _Pragma("unroll") for (int n = 0; n < 2; ++n) _Pragma("unroll") for (int k = 0; k < 2; ++k) dst[n][k] = *(const LAS bf16x8*)(lds + PG8_SB(b, h) + boff + n * 2048 + k * 1024); } while (0)
#define PG8_MMA(ai, bj, At, Bt) do { __builtin_amdgcn_s_setprio(1); _Pragma("unroll") for (int m = 0; m < 4; ++m) _Pragma("unroll") for (int n = 0; n < 2; ++n) _Pragma("unroll") for (int k = 0; k < 2; ++k) \
        acc[ai][bj][m][n] = __builtin_amdgcn_mfma_f32_16x16x32_bf16(Bt[n][k], At[m][k], acc[ai][bj][m][n], 0, 0, 0); __builtin_amdgcn_s_setprio(0); } while (0)
#define PG8_WAIT_V(n) asm volatile("s_waitcnt vmcnt(" #n ")" ::: "memory")
#define PG8_WAIT_L(n) asm volatile("s_waitcnt lgkmcnt(" #n ")" ::: "memory")
#define PG8_BAR __builtin_amdgcn_s_barrier()
#define PG8_SCHED __builtin_amdgcn_sched_barrier(0)
    Unit cur, nxt; int ui = 0;
    if (!S.next(0, cur)) return;
    f32x4 acc[2][2][4][2];
#pragma unroll
    for (int a = 0; a < 2; ++a)
#pragma unroll
        for (int b = 0; b < 2; ++b)
#pragma unroll
            for (int m = 0; m < 4; ++m)
#pragma unroll
                for (int n = 0; n < 2; ++n) acc[a][b][m][n] = (f32x4){0.f, 0.f, 0.f, 0.f};
    bf16x8 At[4][2], B0[2][2], B1[2][2];
    const char* cA = (const char*)gA + (size_t)cur.pm * tstepA + (size_t)cur.ka * 2; const char* cB = (const char*)gBt + (size_t)cur.pn * tstepB;
    PG8_STAGE(PG8_SB(0, 0), cB, voffB); PG8_STAGE(PG8_SA(0, 0), cA, voffA); PG8_STAGE(PG8_SB(0, 1), cB + hstepB, voffB); PG8_STAGE(PG8_SA(0, 1), cA + hstepA, voffA);
    if (wr == 1) PG8_BAR;
    PG8_WAIT_V(4); PG8_BAR;
    PG8_STAGE(PG8_SB(1, 0), cB + kstep, voffB); PG8_STAGE(PG8_SA(1, 0), cA + kstep, voffA); PG8_STAGE(PG8_SB(1, 1), cB + hstepB + kstep, voffB);
    PG8_WAIT_V(6); PG8_BAR;
    for (;;) {
        const bool has_next = S.next(ui + 1, nxt);
        const char* nA = has_next ? (const char*)gA + (size_t)nxt.pm * tstepA + (size_t)nxt.ka * 2 : cA; const char* nB = has_next ? (const char*)gBt + (size_t)nxt.pn * tstepB : cB;
#pragma unroll 1
        for (int t = 0; t < nt; t += 2) {
            const bool last = (t == nt - 2);
            const char* a1 = cA + (size_t)(t + 1) * kstep;
            const char* a2 = last ? nA : cA + (size_t)(t + 2) * kstep; const char* b2 = last ? nB : cB + (size_t)(t + 2) * kstep;
            const char* a3 = a2 + kstep; const char* b3 = b2 + kstep;
            PG8_LDB(B0, 0, 0); PG8_SCHED; PG8_LDA(At, 0, 0); PG8_STAGE(PG8_SA(1, 1), a1 + hstepA, voffA);
            PG8_WAIT_L(8); PG8_BAR; PG8_WAIT_L(0); PG8_MMA(0, 0, At, B0); PG8_BAR; PG8_SCHED;
            PG8_LDB(B1, 0, 1); PG8_STAGE(PG8_SB(0, 0), b2, voffB);
            PG8_BAR; PG8_WAIT_L(0); PG8_MMA(0, 1, At, B1); PG8_BAR;
            PG8_LDA(At, 0, 1); PG8_STAGE(PG8_SA(0, 0), a2, voffA);
            PG8_BAR; PG8_WAIT_L(0); PG8_MMA(1, 0, At, B0); PG8_BAR; PG8_SCHED;
            PG8_STAGE(PG8_SB(0, 1), b2 + hstepB, voffB);
            PG8_WAIT_V(6); PG8_BAR; PG8_MMA(1, 1, At, B1); PG8_BAR;
            PG8_LDB(B0, 1, 0); PG8_SCHED; PG8_LDA(At, 1, 0); PG8_STAGE(PG8_SA(0, 1), a2 + hstepA, voffA);
            PG8_WAIT_L(8); PG8_BAR; PG8_WAIT_L(0); PG8_MMA(0, 0, At, B0); PG8_BAR; PG8_SCHED;
            PG8_LDB(B1, 1, 1); PG8_STAGE(PG8_SB(1, 0), b3, voffB);
            PG8_BAR; PG8_WAIT_L(0); PG8_MMA(0, 1, At, B1); PG8_BAR;
            PG8_LDA(At, 1, 1); PG8_STAGE(PG8_SA(1, 0), a3, voffA);
            PG8_BAR; PG8_WAIT_L(0); PG8_MMA(1, 0, At, B0); PG8_BAR; PG8_SCHED;
            PG8_STAGE(PG8_SB(1, 1), b3 + hstepB, voffB);
            PG8_WAIT_V(6); PG8_BAR; PG8_MMA(1, 1, At, B1); PG8_BAR;
        }
        E(acc, cur, wr, wc, fr, fq);
        if (!has_next) break;
#pragma unroll
        for (int a = 0; a < 2; ++a)
#pragma unroll
            for (int b = 0; b < 2; ++b)
#pragma unroll
                for (int m = 0; m < 4; ++m)
#pragma unroll
                    for (int n = 0; n < 2; ++n) acc[a][b][m][n] = (f32x4){0.f, 0.f, 0.f, 0.f};
        cur = nxt; cA = nA; cB = nB; ++ui;
    }
    PG8_WAIT_V(0);
    if (wr == 0) PG8_BAR;
    PG8_BAR;
#undef PG8_SA
#undef PG8_SB
#undef PG8_STAGE
#undef PG8_LDA
#undef PG8_LDB
#undef PG8_MMA
#undef PG8_WAIT_V
#undef PG8_WAIT_L
#undef PG8_BAR
#undef PG8_SCHED
}
}
using pg8::Unit;

template <bool HIDM> struct EpiBfT {
    static constexpr bool PERM = true;
    bf16_t* O; int ldc; int pnmask; const float* bias; const float* ssp;
    __device__ __forceinline__ void operator()(const f32x4 (&acc)[2][2][4][2], const Unit& u, int wr, int wc, int fr, int fq) const {
        const int row0 = u.pm * 256 + wr * 64 + fr; const int colt = (u.pn & pnmask) * 256; const int col0 = colt + wc * 32 + 8 * fq;
        f32x4 hb[2][2];
#pragma unroll
        for (int bj = 0; bj < 2; ++bj) { hb[bj][0] = (f32x4){0.f, 0.f, 0.f, 0.f}; hb[bj][1] = hb[bj][0];
            if (HIDM) { const float* bp = bias + u.pn * 256 + wc * 32 + 8 * fq + bj * 128; hb[bj][0] = *(const f32x4*)bp; hb[bj][1] = *(const f32x4*)(bp + 4); } }
        float rscv[2][4];
#pragma unroll
        for (int ai = 0; ai < 2; ++ai)
#pragma unroll
            for (int m = 0; m < 4; ++m) rscv[ai][m] = 1.f;
        if (!HIDM && ssp && u.pm < 64) {
#pragma unroll
            for (int ai = 0; ai < 2; ++ai)
#pragma unroll
                for (int mh = 0; mh < 2; ++mh) { f32x4 t[2][4];
#pragma unroll
                    for (int mm = 0; mm < 2; ++mm)
#pragma unroll
                        for (int i = 0; i < 4; ++i) t[mm][i] = ((const f32x4*)(ssp + (size_t)(row0 + ai * 128 + (mh * 2 + mm) * 16) * 16))[i];
#pragma unroll
                    for (int mm = 0; mm < 2; ++mm) { const f32x4 a = t[mm][0] + t[mm][1] + t[mm][2] + t[mm][3]; rscv[ai][mh * 2 + mm] = rsqrtf((a[0] + a[1] + a[2] + a[3]) * (1.f / 1024.f) + 1e-6f); } } }
#pragma unroll
        for (int ai = 0; ai < 2; ++ai)
#pragma unroll
            for (int m = 0; m < 4; ++m) { bf16_t* rowp = O + (size_t)(row0 + ai * 128 + m * 16) * ldc + col0;
                const float rsc = rscv[ai][m];
#pragma unroll
                for (int bj = 0; bj < 2; ++bj) { f32x4 v0 = acc[ai][bj][m][0] * rsc, v1 = acc[ai][bj][m][1] * rsc;
                    if (HIDM) {
#pragma unroll
                        for (int e = 0; e < 4; ++e) { v0[e] = gelu_t(v0[e] + hb[bj][0][e]); v1[e] = gelu_t(v1[e] + hb[bj][1][e]); } }
                    u32x4 w; w.x = pk2(v0[0], v0[1]); w.y = pk2(v0[2], v0[3]); w.z = pk2(v1[0], v1[1]); w.w = pk2(v1[2], v1[3]);
                    *(u32x4*)(rowp + bj * 128) = w; } }
    }
};
typedef EpiBfT<false> EpiBf; typedef EpiBfT<true> EpiHid;
struct EpiMerge {
    static constexpr bool PERM = false;
    const bf16_t* P; bf16_t* M;
    __device__ __forceinline__ void operator()(const f32x4 (&acc)[2][2][4][2], const Unit& u, int wr, int wc, int fr, int fq) const {
        const int oc = u.pn * 64 + wc * 16 + fq * 4;
        u32x2 pv[2][4][4];
#pragma unroll
        for (int ai = 0; ai < 2; ++ai)
#pragma unroll
            for (int m = 0; m < 4; ++m) { const int row = u.pm * 256 + ai * 128 + wr * 64 + m * 16 + fr;
#pragma unroll
                for (int br = 0; br < 4; ++br) pv[ai][m][br] = *(const u32x2*)(P + ((size_t)br * T_ + row) * 2048 + oc); }
#pragma unroll
        for (int ai = 0; ai < 2; ++ai)
#pragma unroll
            for (int m = 0; m < 4; ++m) { const int row = u.pm * 256 + ai * 128 + wr * 64 + m * 16 + fr;
                float r0 = 0.f, r1 = 0.f, r2 = 0.f, r3 = 0.f;
#pragma unroll
                for (int br = 0; br < 4; ++br) { const u32x2 p = pv[ai][m][br]; const f32x4 a = acc[ai][br >> 1][m][br & 1];
                    r0 += sigm(a[0]) * bf2f((bf16_t)(p.x & 0xffff)); r1 += sigm(a[1]) * bf2f((bf16_t)(p.x >> 16));
                    r2 += sigm(a[2]) * bf2f((bf16_t)(p.y & 0xffff)); r3 += sigm(a[3]) * bf2f((bf16_t)(p.y >> 16)); }
                u32x2 w; w.x = pk2(r0, r1); w.y = pk2(r2, r3); *(u32x2*)(M + (size_t)row * 2048 + oc) = w; }
    }
};
template <bool HASPP> struct EpiResidT {
    static constexpr bool PERM = false;
    float* X; const bf16_t* PP;
    __device__ __forceinline__ void operator()(const f32x4 (&acc)[2][2][4][2], const Unit& u, int wr, int wc, int fr, int fq) const {
        constexpr int NB = HASPP ? 2 : 4;
#pragma unroll
        for (int ai = 0; ai < 2; ++ai)
#pragma unroll
            for (int mh = 0; mh < 4 / NB; ++mh) {
                f32x4 xv[NB][2][2]; u32x2 pp[NB][2][2];
#pragma unroll
                for (int mm = 0; mm < NB; ++mm) { const int row = u.pm * 256 + ai * 128 + wr * 64 + (mh * NB + mm) * 16 + fr;
#pragma unroll
                    for (int bj = 0; bj < 2; ++bj)
#pragma unroll
                        for (int n = 0; n < 2; ++n) { const int col = u.pn * 256 + bj * 128 + wc * 32 + n * 16 + 4 * fq;
                            xv[mm][bj][n] = *(const f32x4*)(X + (size_t)row * 2048 + col); if (HASPP) pp[mm][bj][n] = *(const u32x2*)(PP + (size_t)row * 2048 + col); } }
#pragma unroll
                for (int mm = 0; mm < NB; ++mm) { const int m = mh * NB + mm; const int row = u.pm * 256 + ai * 128 + wr * 64 + m * 16 + fr;
#pragma unroll
                    for (int bj = 0; bj < 2; ++bj)
#pragma unroll
                        for (int n = 0; n < 2; ++n) { const int col = u.pn * 256 + bj * 128 + wc * 32 + n * 16 + 4 * fq; float* xp = X + (size_t)row * 2048 + col;
                            f32x4 x = xv[mm][bj][n]; const f32x4 a = acc[ai][bj][m][n];
                            if (HASPP) { const u32x2 p = pp[mm][bj][n];
                                x[0] += sigm(a[0]) * bf2f((bf16_t)(p.x & 0xffff)); x[1] += sigm(a[1]) * bf2f((bf16_t)(p.x >> 16));
                                x[2] += sigm(a[2]) * bf2f((bf16_t)(p.y & 0xffff)); x[3] += sigm(a[3]) * bf2f((bf16_t)(p.y >> 16)); }
                            else x += a;
                            *(f32x4*)xp = x; } }
            }
    }
};
struct EpiFfn {
    static constexpr bool PERM = true;
    bf16_t* ACT; bf16_t* USIDE; const float* cw; const float* cb;
    __device__ __forceinline__ void operator()(const f32x4 (&acc)[2][2][4][2], const Unit& u, int wr, int wc, int fr, int fq) const {
        const int lane = fq * 16 + fr, src1 = (lane & 48) | ((fr + 15) & 15), src2 = (lane & 48) | ((fr + 14) & 15);
        f32x4 wq[2][8];
#pragma unroll
        for (int n = 0; n < 2; ++n) { const int ch = u.pn * 128 + wc * 32 + 8 * fq + 4 * n;
            wq[n][0] = *(const f32x4*)(cw + ch); wq[n][1] = *(const f32x4*)(cw + 12288 + ch); wq[n][2] = *(const f32x4*)(cw + 24576 + ch); wq[n][3] = *(const f32x4*)(cb + ch);
            wq[n][4] = *(const f32x4*)(cw + 6144 + ch); wq[n][5] = *(const f32x4*)(cw + 12288 + 6144 + ch); wq[n][6] = *(const f32x4*)(cw + 24576 + 6144 + ch); wq[n][7] = *(const f32x4*)(cb + 6144 + ch); }
#pragma unroll
        for (int n = 0; n < 2; ++n) { const int ch = u.pn * 128 + wc * 32 + 8 * fq + 4 * n;
            const f32x4 wg0 = wq[n][0], wg1 = wq[n][1], wg2 = wq[n][2], bg = wq[n][3];
            const f32x4 wv0 = wq[n][4], wv1 = wq[n][5], wv2 = wq[n][6], bv = wq[n][7];
#pragma unroll
            for (int ai = 0; ai < 2; ++ai) { f32x4 g1p = (f32x4){0.f, 0.f, 0.f, 0.f}, g2p = g1p, v1p = g1p, v2p = g1p;
#pragma unroll
                for (int m = 0; m < 4; ++m) { const f32x4 ug = acc[ai][0][m][n], uv = acc[ai][1][m][n]; f32x4 g1, g2, v1, v2;
#pragma unroll
                    for (int e = 0; e < 4; ++e) {
                        g1[e] = __int_as_float(__builtin_amdgcn_update_dpp(0, __float_as_int(ug[e]), 0x121, 0xF, 0xF, false)); g2[e] = __int_as_float(__builtin_amdgcn_update_dpp(0, __float_as_int(ug[e]), 0x122, 0xF, 0xF, false));
                        v1[e] = __int_as_float(__builtin_amdgcn_update_dpp(0, __float_as_int(uv[e]), 0x121, 0xF, 0xF, false)); v2[e] = __int_as_float(__builtin_amdgcn_update_dpp(0, __float_as_int(uv[e]), 0x122, 0xF, 0xF, false)); }
                    const f32x4 pg1 = fr >= 1 ? g1 : g1p, pg2 = fr >= 2 ? g2 : g2p, pv1 = fr >= 1 ? v1 : v1p, pv2 = fr >= 2 ? v2 : v2p;
                    const int row = u.pm * 256 + ai * 128 + wr * 64 + m * 16 + fr;
                    const f32x4 yg = bg + wg0 * pg2 + wg1 * pg1 + wg2 * ug, yv = bv + wv0 * pv2 + wv1 * pv1 + wv2 * uv;
                    if (m > 0 || fr >= 2) { u32x2 w; w.x = pk2(gelu_t(yg[0]) * yv[0], gelu_t(yg[1]) * yv[1]); w.y = pk2(gelu_t(yg[2]) * yv[2], gelu_t(yg[3]) * yv[3]); *(u32x2*)(ACT + (size_t)row * 6144 + ch) = w; }
                    if ((m == 0 && fr < 2) || (m == 3 && fr >= 14)) { bf16_t* sp = USIDE + ((size_t)(row >> 6) * 4 + (m == 0 ? fr : fr - 12)) * 12288 + ch;
                        u32x2 w; w.x = pk2(ug[0], ug[1]); w.y = pk2(ug[2], ug[3]); *(u32x2*)sp = w; w.x = pk2(uv[0], uv[1]); w.y = pk2(uv[2], uv[3]); *(u32x2*)(sp + 6144) = w; }
                    g1p = g1; g2p = g2; v1p = v1; v2p = v2; } } }
    }
};
struct EpiRG {
    static constexpr bool PERM = false;
    const bf16_t* XC; const float* b_r; const float* b_i; const float* spl; bf16_t* LA; bf16_t* UU;
    __device__ __forceinline__ void operator()(const f32x4 (&acc)[2][2][4][2], const Unit& u, int wr, int wc, int fr, int fq) const {
#pragma unroll
        for (int n = 0; n < 2; ++n) { const int ch = u.pn * 128 + wc * 32 + n * 16 + 4 * fq;
            const f32x4 br = *(const f32x4*)(b_r + ch), bi = *(const f32x4*)(b_i + ch), sp = *(const f32x4*)(spl + ch);
            u32x2 xvb[2][4];
#pragma unroll
            for (int ai = 0; ai < 2; ++ai)
#pragma unroll
                for (int m = 0; m < 4; ++m) xvb[ai][m] = *(const u32x2*)(XC + (size_t)(u.pm * 256 + ai * 128 + wr * 64 + m * 16 + fr) * 1024 + ch);
#pragma unroll
            for (int ai = 0; ai < 2; ++ai)
#pragma unroll
                for (int m = 0; m < 4; ++m) { const size_t off = (size_t)(u.pm * 256 + ai * 128 + wr * 64 + m * 16 + fr) * 1024 + ch;
                    const u32x2 xv = xvb[ai][m];
                    const f32x4 ar = acc[ai][0][m][n], aig = acc[ai][1][m][n];
                    const float l0 = sp[0] * sigm(ar[0] + br[0]), l1 = sp[1] * sigm(ar[1] + br[1]), l2 = sp[2] * sigm(ar[2] + br[2]), l3 = sp[3] * sigm(ar[3] + br[3]);
                    u32x2 w; w.x = pk2(l0, l1); w.y = pk2(l2, l3); *(u32x2*)(LA + off) = w;
                    const float u0 = sqrtf(fmaxf(1.f - __expf(2.f * l0), 0.f)) * sigm(aig[0] + bi[0]) * bf2f((bf16_t)(xv.x & 0xffff));
                    const float u1 = sqrtf(fmaxf(1.f - __expf(2.f * l1), 0.f)) * sigm(aig[1] + bi[1]) * bf2f((bf16_t)(xv.x >> 16));
                    const float u2 = sqrtf(fmaxf(1.f - __expf(2.f * l2), 0.f)) * sigm(aig[2] + bi[2]) * bf2f((bf16_t)(xv.y & 0xffff));
                    const float u3 = sqrtf(fmaxf(1.f - __expf(2.f * l3), 0.f)) * sigm(aig[3] + bi[3]) * bf2f((bf16_t)(xv.y >> 16));
                    w.x = pk2(u0, u1); w.y = pk2(u2, u3); *(u32x2*)(UU + off) = w; } }
    }
};

template <class F>
__device__ __forceinline__ void convT(int tidv, int bidv, const F& rowsrc, int K, int ld, bf16_t* dst, int nrows, LAS float* tile) {
    const int tid = tidv, nkt = K >> 6, ntiles = (nrows >> 6) * nkt;
    const int kk0 = tid >> 4, n4 = tid & 15;
    f32x4 v0 = (f32x4){0.f, 0.f, 0.f, 0.f}, v1 = v0;
    int tl = bidv;
    if (tl < ntiles) { const int rt = tl / nkt, kt = tl - rt * nkt; const float* src = rowsrc(rt * 64 + n4 * 4);
        if (src) { v0 = *(const f32x4*)(src + (size_t)(kt * 64 + kk0) * ld); v1 = *(const f32x4*)(src + (size_t)(kt * 64 + kk0 + 32) * ld); } }
    for (; tl < ntiles; tl += gridDim.x) {
        const int rt = tl / nkt, kt = tl - rt * nkt;
        { LAS float* tp = tile + kk0 * 65 + n4 * 4; tp[0] = v0[0]; tp[1] = v0[1]; tp[2] = v0[2]; tp[3] = v0[3];
          tp += 32 * 65; tp[0] = v1[0]; tp[1] = v1[1]; tp[2] = v1[2]; tp[3] = v1[3]; }
        { const int nx = tl + gridDim.x; v0 = (f32x4){0.f, 0.f, 0.f, 0.f}; v1 = v0;
          if (nx < ntiles) { const int rt2 = nx / nkt, kt2 = nx - rt2 * nkt; const float* src = rowsrc(rt2 * 64 + n4 * 4);
              if (src) { v0 = *(const f32x4*)(src + (size_t)(kt2 * 64 + kk0) * ld); v1 = *(const f32x4*)(src + (size_t)(kt2 * 64 + kk0 + 32) * ld); } } }
        __syncthreads();
        { const int jj = tid >> 3, k8 = tid & 7; float f[8];
#pragma unroll
          for (int e = 0; e < 8; ++e) f[e] = tile[(k8 * 8 + e) * 65 + jj];
          *(u32x4*)(dst + (size_t)(rt * 64 + jj) * K + kt * 64 + k8 * 8) = pack8(f); }
        __syncthreads();
    }
}
__device__ __forceinline__ void rms_rows(int tidv, int bidv, const float* Xin, const float* g, bf16_t* H, float* Xc) {
    const int lane = tidv & 63, wv = tidv >> 6;
    for (int row = (bidv * 8 + wv) * 2; row < T_; row += gridDim.x * 16) {
        const float* xr = Xin + (size_t)row * 2048; f32x4 v[2][8]; float ss0 = 0.f, ss1 = 0.f;
#pragma unroll
        for (int i = 0; i < 8; ++i) { v[0][i] = *(const f32x4*)(xr + i * 256 + lane * 4); v[1][i] = *(const f32x4*)(xr + 2048 + i * 256 + lane * 4); }
#pragma unroll
        for (int i = 0; i < 8; ++i) { ss0 += v[0][i][0] * v[0][i][0] + v[0][i][1] * v[0][i][1] + v[0][i][2] * v[0][i][2] + v[0][i][3] * v[0][i][3];
                                      ss1 += v[1][i][0] * v[1][i][0] + v[1][i][1] * v[1][i][1] + v[1][i][2] * v[1][i][2] + v[1][i][3] * v[1][i][3]; }
#pragma unroll
        for (int o = 32; o >= 1; o >>= 1) { ss0 += __shfl_xor(ss0, o); ss1 += __shfl_xor(ss1, o); }
        const float rs[2] = {rsqrtf(ss0 * (1.0f / 2048.0f) + 1e-6f), rsqrtf(ss1 * (1.0f / 2048.0f) + 1e-6f)};
#pragma unroll
        for (int i = 0; i < 8; ++i) { const f32x4 gg = *(const f32x4*)(g + i * 256 + lane * 4);
#pragma unroll
            for (int r = 0; r < 2; ++r) { u32x2 w; w.x = pk2(v[r][i][0] * rs[r] * gg[0], v[r][i][1] * rs[r] * gg[1]); w.y = pk2(v[r][i][2] * rs[r] * gg[2], v[r][i][3] * rs[r] * gg[3]);
                *(u32x2*)(H + (size_t)(row + r) * 2048 + i * 256 + lane * 4) = w; if (Xc) *(f32x4*)(Xc + (size_t)(row + r) * 2048 + i * 256 + lane * 4) = v[r][i]; } }
    }
}

__constant__ double kInvFreqRev[32] = {0.15915494309189535, 0.11934937021124886, 0.08949940160889101, 0.06711508300522726, 0.050329212104487035, 0.03774158471741977, 0.0283021958306234, 0.02122365276477766, 0.015915494309189534, 0.011934937021124886, 0.008949940160889102, 0.006711508300522725, 0.005032921210448704, 0.003774158471741977, 0.00283021958306234, 0.0021223652764777662, 0.0015915494309189536, 0.0011934937021124885, 0.0008949940160889102, 0.0006711508300522726, 0.0005032921210448703, 0.00037741584717419774, 0.00028302195830623395, 0.0002122365276477766, 0.00015915494309189535, 0.00011934937021124886, 8.949940160889102e-05, 6.711508300522725e-05, 5.0329212104487035e-05, 3.774158471741978e-05, 2.8302195830623396e-05, 2.122365276477766e-05};
constexpr float LOG2E = 1.4426950408889634f;
typedef unsigned u32v2 __attribute__((ext_vector_type(2)));
__device__ __forceinline__ float rmax4(float v) {
    u32v2 r = __builtin_amdgcn_permlane16_swap(__float_as_uint(v), __float_as_uint(v), false, false); v = fmaxf(__uint_as_float(r.x), __uint_as_float(r.y));
    r = __builtin_amdgcn_permlane32_swap(__float_as_uint(v), __float_as_uint(v), false, false); return fmaxf(__uint_as_float(r.x), __uint_as_float(r.y)); }
__device__ __forceinline__ float rsum4(float v) {
    u32v2 r = __builtin_amdgcn_permlane16_swap(__float_as_uint(v), __float_as_uint(v), false, false); v = __uint_as_float(r.x) + __uint_as_float(r.y);
    r = __builtin_amdgcn_permlane32_swap(__float_as_uint(v), __float_as_uint(v), false, false); return __uint_as_float(r.x) + __uint_as_float(r.y); }

__device__ __forceinline__ s16x4 tr_read(const LAS bf16_t* p) { return __builtin_amdgcn_ds_read_tr16_b64_v4i16((LAS s16x4*)p); }
__device__ __forceinline__ void stage_rows(int tidv, LAS bf16_t* dst, int ldd, const bf16_t* src, size_t lds_, int nrows, int ncols) {
    const int cpr = ncols >> 3, n = nrows * cpr;
    for (int idx = tidv; idx < n; idx += 512) { const int r = idx / cpr, sg = idx - r * cpr;
        const u32x4 v = *(const u32x4*)(src + (size_t)r * lds_ + sg * 8); *(LAS u32x4*)(dst + r * ldd + sg * 8) = v; }
}
__device__ __forceinline__ void qk_tile(const LAS bf16_t* Ks, const bf16x8 (&qf)[2], f32x4 (&s)[4], int li, int lg) {
#pragma unroll
    for (int kt = 0; kt < 4; ++kt) { s[kt] = (f32x4){0.f, 0.f, 0.f, 0.f};
#pragma unroll
        for (int ks = 0; ks < 2; ++ks) { const bf16x8 kf = *(const LAS bf16x8*)(Ks + (kt * 16 + li) * 72 + ks * 32 + lg * 8); s[kt] = __builtin_amdgcn_mfma_f32_16x16x32_bf16(kf, qf[ks], s[kt], 0, 0, 0); } }
}
template <int DV, int VLD>
__device__ __forceinline__ void pv_tile(const LAS bf16_t* Vs, const f32x4 (&p)[4], f32x4 (&o)[DV / 16], int li, int lg) {
#pragma unroll
    for (int kp = 0; kp < 2; ++kp) {
        bf16x8 pf;
        { const unsigned a0 = pk2(p[2 * kp][0], p[2 * kp][1]), a1 = pk2(p[2 * kp][2], p[2 * kp][3]), a2 = pk2(p[2 * kp + 1][0], p[2 * kp + 1][1]), a3 = pk2(p[2 * kp + 1][2], p[2 * kp + 1][3]);
          pf[0] = (short)(a0 & 0xffff); pf[1] = (short)(a0 >> 16); pf[2] = (short)(a1 & 0xffff); pf[3] = (short)(a1 >> 16); pf[4] = (short)(a2 & 0xffff); pf[5] = (short)(a2 >> 16); pf[6] = (short)(a3 & 0xffff); pf[7] = (short)(a3 >> 16); }
#pragma unroll
        for (int mt = 0; mt < DV / 16; ++mt) {
            const s16x4 v0 = tr_read(Vs + ((2 * kp) * 16 + lg * 4 + (li >> 2)) * VLD + mt * 16 + (li & 3) * 4);
            const s16x4 v1 = tr_read(Vs + ((2 * kp + 1) * 16 + lg * 4 + (li >> 2)) * VLD + mt * 16 + (li & 3) * 4);
            bf16x8 vf; vf[0] = v0[0]; vf[1] = v0[1]; vf[2] = v0[2]; vf[3] = v0[3]; vf[4] = v1[0]; vf[5] = v1[1]; vf[6] = v1[2]; vf[7] = v1[3];
            o[mt] = __builtin_amdgcn_mfma_f32_16x16x32_bf16(vf, pf, o[mt], 0, 0, 0);
        }
    }
}
template <int DV, int VLD, bool MASKED, class MF>
__device__ __forceinline__ void attn_tile(const LAS bf16_t* Ks, const LAS bf16_t* Vs, const bf16x8 (&qf)[2], f32x4 (&o)[DV / 16], float& m, float& l, int li, int lg, const MF& valid) {
    f32x4 s[4]; qk_tile(Ks, qf, s, li, lg);
    float mx = -1e30f;
#pragma unroll
    for (int kt = 0; kt < 4; ++kt)
#pragma unroll
        for (int j = 0; j < 4; ++j) { float sv = s[kt][j] * LOG2E; if (MASKED) sv = valid(kt * 16 + lg * 4 + j) ? sv : -1e30f; s[kt][j] = sv; mx = fmaxf(mx, sv); }
    mx = rmax4(mx);
    if (!__all(mx <= m)) {
        const float mn = fmaxf(m, mx), alpha = __builtin_amdgcn_exp2f(m - mn); m = mn; l *= alpha;
#pragma unroll
        for (int mt = 0; mt < DV / 16; ++mt) o[mt] *= alpha; }
    float ps = 0.f;
#pragma unroll
    for (int kt = 0; kt < 4; ++kt)
#pragma unroll
        for (int j = 0; j < 4; ++j) { float pv = __builtin_amdgcn_exp2f(s[kt][j] - m); if (MASKED) pv = (s[kt][j] > -1e29f) ? pv : 0.f; s[kt][j] = pv; ps += pv; }
    l += ps;
    pv_tile<DV, VLD>(Vs, s, o, li, lg);
}
__device__ __forceinline__ float lsum4(float l) { return rsum4(l); }

struct Ctx { const Params* p; unsigned char* ws; LAS unsigned char* lds; int tid, lane, wv; };

__device__ __forceinline__ int queue_pop(int tidv, LAS unsigned char* lds, unsigned* ctr) {
    LAS int* s_item = (LAS int*)(lds + LDS_MISC);
    __syncthreads();
    if (tidv == 0) *s_item = (int)atomicAdd(ctr, 1u);
    __syncthreads();
    return *s_item;
}

__device__ void phase_w_a(int tidv, int bidv, KP P, int L, LAS unsigned char* lds) {
    unsigned char* ws = P->ws; const int tid = tidv;
    LAS float* tile = (LAS float*)lds;
    if (L == 0) {
        if (bidv == 0 && tid < 64) ((unsigned*)(ws + PS_CTR))[tid] = 0u;
        float2* rope = (float2*)(ws + PS_ROPE);
        for (int idx = bidv * 512 + tid; idx < S_ * 32; idx += gridDim.x * 512) { const int s = idx >> 5, i = idx & 31;
            double rv = (double)s * kInvFreqRev[i]; rv -= (double)(long long)rv; const float rf = (float)rv; rope[idx] = make_float2(__builtin_amdgcn_cosf(rf), __builtin_amdgcn_sinf(rf)); }
    }
    if (L == 0) rms_rows(tidv, bidv, P->in[0], P->in[2], (bf16_t*)(ws + OFF_H), P->X); else rms_rows(tidv, bidv, P->X, P->in[2] + 2048, (bf16_t*)(ws + OFF_H), nullptr);
    if (bidv == gridDim.x - 1) { const int sub = tid >> 8, j = tid & 255; const float* w1 = (sub ? P->in[20] : P->in[18]) + (size_t)L * 2048 * 256; const float* pos = P->in[17] + L * 2048;
        float a = 0.f; for (int k = 0; k < 2048; ++k) a += pos[k] * w1[k * 256 + j]; ((float*)(ws + PS_C1))[tid] = a; }
    if (bidv == gridDim.x - 2) for (int i = tid; i < 1024; i += 512) ((float*)(ws + PS_SPL))[i] = -8.0f * softplus_(-P->in[28][L * 1024 + i]);
    if (bidv == gridDim.x - 3 && tid == 0) { float d1 = 0.f, d2 = 0.f; for (int i = 0; i < 64; ++i) { d1 += P->in[12][L * 64 + i] * P->in[13][L * 64 + i]; d2 += P->in[14][L * 64 + i] * P->in[15][L * 64 + i]; }
        *(float*)(ws + PS_LAM) = __expf(d1) - __expf(d2) + (L == 0 ? 0.2f : 0.35550906759f); }
    { bf16_t* rg = (bf16_t*)(ws + W_RG); const float* wr_ = P->in[24] + (size_t)L * 16 * 4096; const float* wi_ = P->in[26] + (size_t)L * 16 * 4096;
      for (int idx = bidv * 512 + tid; idx < 2048 * 256; idx += gridDim.x * 512) { const int j = idx >> 8, k = idx & 255, pn = j >> 8, c = j & 255, gate = c >> 7, ch = pn * 128 + (c & 127), hb = ch >> 6, o = ch & 63;
          const int ic = 256 * (pn >> 1) + k; float v = 0.f; if ((ic >> 6) == hb) v = (gate ? wi_ : wr_)[(size_t)hb * 4096 + (ic & 63) * 64 + o]; rg[idx] = f2bf(v); } }
    { const float* w = P->in[5] + (size_t)L * 2048 * 10304; convT(tidv, bidv, [=](int j) { return j < 10304 ? w + j : (const float*)nullptr; }, 2048, 10304, (bf16_t*)(ws + W_IN), 10496, tile); }
    { const float* w = P->in[29] + (size_t)L * 4 * 2048 * 2048; convT(tidv, bidv, [=](int j) { const int pn = j >> 8, c = j & 255, bj = c >> 7, wc = (c >> 5) & 3, n = (c >> 4) & 1, fq = (c >> 2) & 3, e = c & 3;
            return w + (size_t)(2 * bj + n) * 2048 * 2048 + (pn * 64 + wc * 16 + fq * 4 + e); }, 2048, 2048, (bf16_t*)(ws + W_G), 8192, tile); }
    { const float* w = P->in[30] + (size_t)L * 4 * 1024 * 2048; convT(tidv, bidv, [=](int j) { return w + (size_t)(j >> 11) * 1024 * 2048 + (j & 2047); }, 1024, 2048, (bf16_t*)(ws + W_B), 8192, tile); }
    { const float* w = P->in[31] + (size_t)L * 2048 * 2048; convT(tidv, bidv, [=](int j) { return w + j; }, 2048, 2048, (bf16_t*)(ws + W_OUT), 2048, tile); }
    { const float* wk = P->in[18] + (size_t)L * 2048 * 256; const float* wv_ = P->in[20] + (size_t)L * 2048 * 256; convT(tidv, bidv, [=](int j) { return j < 256 ? wk + j : wv_ + (j - 256); }, 2048, 256, (bf16_t*)(ws + W_C1), 512, tile); }
}
__device__ void phase_w_b(int tidv, int bidv, KP P, int L, LAS unsigned char* lds) {
    unsigned char* ws = P->ws; LAS float* tile = (LAS float*)lds;
    { const float* w = P->in[32] + (size_t)L * 2048 * 12288; convT(tidv, bidv, [=](int j) { const int pn = j >> 8, c = j & 255; return w + (c < 128 ? 128 * pn + c : 6144 + 128 * pn + (c - 128)); }, 2048, 12288, (bf16_t*)(ws + W_UP), 12288, tile); }
    { const float* w = P->in[35] + (size_t)L * 6144 * 2048; convT(tidv, bidv, [=](int j) { return w + j; }, 6144, 2048, (bf16_t*)(ws + W_DN), 2048, tile); }
    { const float* w = P->in[37] + (size_t)L * 2048 * 2048; convT(tidv, bidv, [=](int j) { return w + j; }, 2048, 2048, (bf16_t*)(ws + W_PG), 2048, tile); }
    { const float* w = P->in[36] + (size_t)L * 256 * 2048; convT(tidv, bidv, [=](int j) { return w + j; }, 256, 2048, (bf16_t*)(ws + W_PP), 2048, tile); }
    { const float* src = P->in[1] + (size_t)L * T_ * 256; bf16_t* dst = (bf16_t*)(ws + W_PB);
      for (size_t i = (size_t)bidv * 512 + tidv; i < (size_t)T_ * 256 / 4; i += (size_t)gridDim.x * 512) { const f32x4 v = *(const f32x4*)(src + i * 4); u32x2 w; w.x = pk2(v[0], v[1]); w.y = pk2(v[2], v[3]); *(u32x2*)(dst + i * 4) = w; } }
}
__device__ void phase_prep(int tidv, int bidv, KP P, int L) {
    unsigned char* ws = P->ws;
    bf16_t* PROJ = (bf16_t*)(ws + OFF_BIG); const float2* rope = (const float2*)(ws + PS_ROPE);
    bf16_t* KC = (bf16_t*)(ws + T_KCVC); bf16_t* VC = KC + (size_t)32 * 2048 * 64;
    bf16_t* XBC = (bf16_t*)(ws + T_XBC); bf16_t* XC = (bf16_t*)(ws + T_XC); float* DT = (float*)(ws + T_DT);
    const float* scw = P->in[6] + L * 4 * 1536; const float* scb = P->in[7] + L * 1536; const float* dtb = P->in[8] + L * 16;
    const float* rcw = P->in[22] + L * 4 * 1024; const float* rcb = P->in[23] + L * 1024;
    for (int i2 = bidv * 512 + tidv; i2 < T_ * 304; i2 += gridDim.x * 512) {
        const int t = i2 / 304, i = (i2 - t * 304) * 2, s = t & 2047, b = t >> 11; bf16_t* prow = PROJ + (size_t)t * LDP;
        if (i < 240) { const int vec = i >> 2, d0 = (i & 3) * 8; int cb; float sc = 1.f;
            if (vec < 16) { cb = B_Q + 64 * vec; sc = 0.125f; } else if (vec < 32) cb = B_K + 64 * (vec - 16); else if (vec < 48) { cb = C_Q + 64 * (vec - 32); sc = 0.125f; }
            else if (vec < 52) cb = C_KS + 64 * (vec - 48); else if (vec < 56) cb = C_KW + 64 * (vec - 52); else cb = C_KC + 64 * (vec - 56);
            const u32x4 a0 = *(const u32x4*)(prow + cb + d0), a1 = *(const u32x4*)(prow + cb + d0 + 8), c0 = *(const u32x4*)(prow + cb + d0 + 32), c1 = *(const u32x4*)(prow + cb + d0 + 40);
            f32x4 cs[8];
#pragma unroll
            for (int e = 0; e < 8; ++e) cs[e] = *(const f32x4*)(rope + s * 32 + d0 + 2 * e);
            float x1[16], x2[16], o1[16], o2[16];
            { float ta[8], tb[8]; unpack8(a0, ta); unpack8(a1, tb);
#pragma unroll
              for (int e = 0; e < 8; ++e) { x1[e] = ta[e]; x1[8 + e] = tb[e]; }
              unpack8(c0, ta); unpack8(c1, tb);
#pragma unroll
              for (int e = 0; e < 8; ++e) { x2[e] = ta[e]; x2[8 + e] = tb[e]; } }
#pragma unroll
            for (int e = 0; e < 16; ++e) { const float cc = cs[e >> 1][(e & 1) * 2], sn = cs[e >> 1][(e & 1) * 2 + 1]; o1[e] = (x1[e] * cc - x2[e] * sn) * sc; o2[e] = (x2[e] * cc + x1[e] * sn) * sc; }
            bf16_t* dst = vec < 56 ? prow + cb : KC + ((size_t)(b * 4 + (vec - 56)) * 2048 + s) * 64;
            { float p[8];
#pragma unroll
              for (int e = 0; e < 8; ++e) p[e] = o1[e];
              *(u32x4*)(dst + d0) = pack8(p);
#pragma unroll
              for (int e = 0; e < 8; ++e) p[e] = o1[8 + e];
              *(u32x4*)(dst + d0 + 8) = pack8(p);
#pragma unroll
              for (int e = 0; e < 8; ++e) p[e] = o2[e];
              *(u32x4*)(dst + d0 + 32) = pack8(p);
#pragma unroll
              for (int e = 0; e < 8; ++e) p[e] = o2[8 + e];
              *(u32x4*)(dst + d0 + 40) = pack8(p); }
        } else if (i < 560) { const bool ssd = i < 432; const int c = ssd ? (i - 240) * 8 : (i - 432) * 8, nch = ssd ? 1536 : 1024, col = (ssd ? A_XBC : D_X) + c;
            const float* cw_ = ssd ? scw : rcw; const float* cb_ = ssd ? scb : rcb;
            u32x4 r[4][2];
#pragma unroll
            for (int k = 0; k < 4; ++k) { const bool ok = s - 3 + k >= 0; const bf16_t* rp = PROJ + (size_t)(t - 3 + k) * LDP + col;
                r[k][0] = ok ? *(const u32x4*)rp : (u32x4){0u, 0u, 0u, 0u}; r[k][1] = ok ? *(const u32x4*)(rp + 8) : (u32x4){0u, 0u, 0u, 0u}; }
            float a[16];
#pragma unroll
            for (int e = 0; e < 16; ++e) a[e] = cb_[c + e];
#pragma unroll
            for (int k = 0; k < 4; ++k) { float x0[8], x1[8]; unpack8(r[k][0], x0); unpack8(r[k][1], x1);
#pragma unroll
                for (int e = 0; e < 8; ++e) { a[e] += cw_[k * nch + c + e] * x0[e]; a[8 + e] += cw_[k * nch + c + 8 + e] * x1[e]; } }
            float p0[8], p1[8];
#pragma unroll
            for (int e = 0; e < 8; ++e) { p0[e] = ssd ? silu_(a[e]) : a[e]; p1[e] = ssd ? silu_(a[8 + e]) : a[8 + e]; }
            bf16_t* dst = (ssd ? XBC + (size_t)t * 1536 : XC + (size_t)t * 1024) + c;
            *(u32x4*)dst = pack8(p0); *(u32x4*)(dst + 8) = pack8(p1);
        } else if (i < 592) { const int q = i - 560, g = q >> 3, d = (q & 7) * 8;
            const u32x4 v0 = *(const u32x4*)(prow + C_VC + q * 8), v1 = *(const u32x4*)(prow + C_VC + q * 8 + 8);
            bf16_t* dst = VC + ((size_t)(b * 4 + g) * 2048 + s) * 64 + d; *(u32x4*)dst = v0; *(u32x4*)(dst + 8) = v1;
        } else { const int hh = i - 592; DT[t * 16 + hh] = softplus_(bf2f(prow[A_DT + hh]) + dtb[hh]); DT[t * 16 + hh + 1] = softplus_(bf2f(prow[A_DT + hh + 1]) + dtb[hh + 1]); }
    }
}

__device__ void item_ssd(int tidv, KP P, int L, LAS unsigned char* lds, int b, int h) {
    unsigned char* ws = P->ws; const int tid = tidv, lane = tid & 63, w = tid >> 6, li = lane & 15, lg = lane >> 4;
    const bf16_t* XBC = (const bf16_t*)(ws + T_XBC); const float* DT = (const float*)(ws + T_DT); bf16_t* O0 = (bf16_t*)(ws + O_O);
    constexpr int CSB = 0, BSB = 17408, XDB = 34816, XWB = 44032, YAB = 53248, YB0B = YAB + 17408, ACSB = YAB + 3 * 17408, DTVB = ACSB + 256;
    LAS bf16_t* Cs = (LAS bf16_t*)(lds + CSB); LAS bf16_t* Bs = (LAS bf16_t*)(lds + BSB); LAS bf16_t* Xd = (LAS bf16_t*)(lds + XDB); LAS bf16_t* Xw = (LAS bf16_t*)(lds + XWB);
    LAS float* yA = (LAS float*)(lds + YAB); LAS float* acs = (LAS float*)(lds + ACSB); LAS float* dtv = (LAS float*)(lds + DTVB);
    const float Aneg = -__expf(P->in[9][L * 16 + h]), Dh = P->in[10][L * 16 + h];
    const bf16_t* PROJ = (const bf16_t*)(ws + OFF_BIG); float* SSP = (float*)(ws + T_SSP);
    const int gi = h >> 3, pt = w & 3, nh = w >> 2, lt = w & 3, pp = w >> 2;
    f32x4 hT[4];
#pragma unroll
    for (int i = 0; i < 4; ++i) hT[i] = (f32x4){0.f, 0.f, 0.f, 0.f};
    const int crow = tid >> 4, cseg = tid & 15, xrow = tid >> 3, xseg = tid & 7;
    float gnr[8];
#pragma unroll
    for (int e = 0; e < 8; ++e) gnr[e] = P->in[11][L * 1024 + h * 64 + xseg * 8 + e];
    const bf16_t* gB = XBC + ((size_t)b * 2048 + crow) * 1536 + 1024 + gi * 128 + cseg * 8;
    const bf16_t* gX = XBC + ((size_t)b * 2048 + xrow) * 1536 + h * 64 + xseg * 8;
    const float* gD = DT + ((size_t)b * 2048 + lane) * 16 + h;
    u32x4 rb0, rb1, rc0, rc1, rx; float rdt = 0.f;
    { rb0 = *(const u32x4*)gB; rb1 = *(const u32x4*)(gB + 32 * 1536); rc0 = *(const u32x4*)(gB + 256); rc1 = *(const u32x4*)(gB + 32 * 1536 + 256); rx = *(const u32x4*)gX; if (w == 0) rdt = *gD; }
    for (int ch = 0; ch < 32; ++ch) {
        __syncthreads();
        { const int o = (crow * 136 + cseg * 8) * 2; *(LAS u32x4*)(lds + BSB + o) = rb0; *(LAS u32x4*)(lds + BSB + o + 32 * 272) = rb1; *(LAS u32x4*)(lds + CSB + o) = rc0; *(LAS u32x4*)(lds + CSB + o + 32 * 272) = rc1; }
        if (w == 0) { float a = rdt * Aneg;
#pragma unroll
            for (int off = 1; off < 64; off <<= 1) { const float t = __shfl_up(a, off); if (lane >= off) a += t; }
            acs[lane] = a; dtv[lane] = rdt; }
        float xr[8]; unpack8(rx, xr);
        __syncthreads();
        if (ch < 31) { const size_t go = (size_t)(ch + 1) * 64 * 1536; rb0 = *(const u32x4*)(gB + go); rb1 = *(const u32x4*)(gB + go + 32 * 1536); rc0 = *(const u32x4*)(gB + go + 256); rc1 = *(const u32x4*)(gB + go + 32 * 1536 + 256);
            rx = *(const u32x4*)(gX + go); if (w == 0) rdt = gD[(size_t)(ch + 1) * 64 * 16]; }
        const u32x4 rz = *(const u32x4*)(PROJ + ((size_t)b * 2048 + ch * 64 + xrow) * LDP + A_Z + h * 64 + xseg * 8);
        { const float d = dtv[xrow], wgt = __expf(acs[63] - acs[xrow]); float xd[8], xw[8];
#pragma unroll
          for (int e = 0; e < 8; ++e) { xd[e] = d * xr[e]; xw[e] = wgt * xd[e]; }
          *(LAS u32x4*)(lds + XDB + (xrow * 72 + xseg * 8) * 2) = pack8(xd); *(LAS u32x4*)(lds + XWB + (xrow * 72 + xseg * 8) * 2) = pack8(xw);
          *(LAS f32x4*)(yA + xrow * 68 + xseg * 8) = (f32x4){Dh * xr[0], Dh * xr[1], Dh * xr[2], Dh * xr[3]}; *(LAS f32x4*)(yA + xrow * 68 + xseg * 8 + 4) = (f32x4){Dh * xr[4], Dh * xr[5], Dh * xr[6], Dh * xr[7]}; }
        __syncthreads();
        { bf16x8 cf[4];
#pragma unroll
          for (int ks = 0; ks < 4; ++ks) cf[ks] = *(const LAS bf16x8*)(Cs + (16 * lt + li) * 136 + ks * 32 + lg * 8);
          const float acl = acs[16 * lt + li];
          f32x4 pw[4];
#pragma unroll
          for (int st = 0; st < 4; ++st) {
              pw[st] = (f32x4){0.f, 0.f, 0.f, 0.f};
              if (st <= lt) { f32x4 g = (f32x4){0.f, 0.f, 0.f, 0.f};
#pragma unroll
                  for (int ks = 0; ks < 4; ++ks) { const bf16x8 bfr = *(const LAS bf16x8*)(Bs + (16 * st + li) * 136 + ks * 32 + lg * 8); g = __builtin_amdgcn_mfma_f32_16x16x32_bf16(bfr, cf[ks], g, 0, 0, 0); }
                  const f32x4 as4 = *(const LAS f32x4*)(acs + 16 * st + 4 * lg);
#pragma unroll
                  for (int j = 0; j < 4; ++j) { float wv = g[j] * __expf(acl - as4[j]); if (st == lt && 4 * lg + j > li) wv = 0.f; pw[st][j] = wv; } }
          }
#pragma unroll
          for (int mt2 = 0; mt2 < 2; ++mt2) { const int mtile = 2 * pp + mt2; f32x4 yT = (f32x4){0.f, 0.f, 0.f, 0.f};
#pragma unroll
              for (int kp = 0; kp < 2; ++kp) if (kp == 0 || lt >= 2) {
                  bf16x8 pf; { const unsigned a0 = pk2(pw[2 * kp][0], pw[2 * kp][1]), a1 = pk2(pw[2 * kp][2], pw[2 * kp][3]), a2 = pk2(pw[2 * kp + 1][0], pw[2 * kp + 1][1]), a3 = pk2(pw[2 * kp + 1][2], pw[2 * kp + 1][3]);
                      pf[0] = (short)(a0 & 0xffff); pf[1] = (short)(a0 >> 16); pf[2] = (short)(a1 & 0xffff); pf[3] = (short)(a1 >> 16); pf[4] = (short)(a2 & 0xffff); pf[5] = (short)(a2 >> 16); pf[6] = (short)(a3 & 0xffff); pf[7] = (short)(a3 >> 16); }
                  const s16x4 v0 = tr_read(Xd + ((2 * kp) * 16 + lg * 4 + (li >> 2)) * 72 + mtile * 16 + (li & 3) * 4);
                  const s16x4 v1 = tr_read(Xd + ((2 * kp + 1) * 16 + lg * 4 + (li >> 2)) * 72 + mtile * 16 + (li & 3) * 4);
                  bf16x8 vf; vf[0] = v0[0]; vf[1] = v0[1]; vf[2] = v0[2]; vf[3] = v0[3]; vf[4] = v1[0]; vf[5] = v1[1]; vf[6] = v1[2]; vf[7] = v1[3];
                  yT = __builtin_amdgcn_mfma_f32_16x16x32_bf16(vf, pf, yT, 0, 0, 0); }
              LAS f32x4* yp = (LAS f32x4*)(yA + (16 * lt + li) * 68 + 16 * mtile + 4 * lg); *yp = *yp + yT; } }
        { LAS float* yB = (LAS float*)(lds + YB0B + nh * 17408);
          bf16x8 hb[2];
#pragma unroll
          for (int k2 = 0; k2 < 2; ++k2) { const unsigned a0 = pk2(hT[2 * k2][0], hT[2 * k2][1]), a1 = pk2(hT[2 * k2][2], hT[2 * k2][3]), a2 = pk2(hT[2 * k2 + 1][0], hT[2 * k2 + 1][1]), a3 = pk2(hT[2 * k2 + 1][2], hT[2 * k2 + 1][3]);
              hb[k2][0] = (short)(a0 & 0xffff); hb[k2][1] = (short)(a0 >> 16); hb[k2][2] = (short)(a1 & 0xffff); hb[k2][3] = (short)(a1 >> 16); hb[k2][4] = (short)(a2 & 0xffff); hb[k2][5] = (short)(a2 >> 16); hb[k2][6] = (short)(a3 & 0xffff); hb[k2][7] = (short)(a3 >> 16); }
#pragma unroll
          for (int l2 = 0; l2 < 4; ++l2) { f32x4 yo = (f32x4){0.f, 0.f, 0.f, 0.f};
#pragma unroll
              for (int k2 = 0; k2 < 2; ++k2) { const u32x2 c0 = *(const LAS u32x2*)(Cs + (16 * l2 + li) * 136 + 16 * (4 * nh + 2 * k2) + 4 * lg), c1 = *(const LAS u32x2*)(Cs + (16 * l2 + li) * 136 + 16 * (4 * nh + 2 * k2 + 1) + 4 * lg);
                  bf16x8 af; af[0] = (short)(c0.x & 0xffff); af[1] = (short)(c0.x >> 16); af[2] = (short)(c0.y & 0xffff); af[3] = (short)(c0.y >> 16); af[4] = (short)(c1.x & 0xffff); af[5] = (short)(c1.x >> 16); af[6] = (short)(c1.y & 0xffff); af[7] = (short)(c1.y >> 16);
                  yo = __builtin_amdgcn_mfma_f32_16x16x32_bf16(af, hb[k2], yo, 0, 0, 0); }
              const f32x4 al = *(const LAS f32x4*)(acs + 16 * l2 + 4 * lg);
#pragma unroll
              for (int j = 0; j < 4; ++j) yB[(16 * l2 + 4 * lg + j) * 68 + 16 * pt + li] = yo[j] * __expf(al[j]); } }
        { const float dec = __expf(acs[63]);
#pragma unroll
          for (int i = 0; i < 4; ++i) hT[i] *= dec;
#pragma unroll
          for (int kp = 0; kp < 2; ++kp) {
              const s16x4 x0 = tr_read(Xw + (32 * kp + 4 * lg + (li >> 2)) * 72 + 16 * pt + (li & 3) * 4), x1 = tr_read(Xw + (32 * kp + 16 + 4 * lg + (li >> 2)) * 72 + 16 * pt + (li & 3) * 4);
              bf16x8 xf; xf[0] = x0[0]; xf[1] = x0[1]; xf[2] = x0[2]; xf[3] = x0[3]; xf[4] = x1[0]; xf[5] = x1[1]; xf[6] = x1[2]; xf[7] = x1[3];
#pragma unroll
              for (int i = 0; i < 4; ++i) { const int ntile = 4 * nh + i;
                  const s16x4 b0 = tr_read(Bs + (32 * kp + 4 * lg + (li >> 2)) * 136 + 16 * ntile + (li & 3) * 4), b1 = tr_read(Bs + (32 * kp + 16 + 4 * lg + (li >> 2)) * 136 + 16 * ntile + (li & 3) * 4);
                  bf16x8 bfr; bfr[0] = b0[0]; bfr[1] = b0[1]; bfr[2] = b0[2]; bfr[3] = b0[3]; bfr[4] = b1[0]; bfr[5] = b1[1]; bfr[6] = b1[2]; bfr[7] = b1[3];
                  hT[i] = __builtin_amdgcn_mfma_f32_16x16x32_bf16(bfr, xf, hT[i], 0, 0, 0); } } }
        __syncthreads();
        { const LAS float* y0 = yA + xrow * 68 + xseg * 8; float v[8], z[8]; const size_t trow = (size_t)b * 2048 + ch * 64 + xrow;
          unpack8(rz, z); float ss = 0.f;
#pragma unroll
          for (int e = 0; e < 8; ++e) { const float t = (y0[e] + y0[4352 + e] + y0[8704 + e]) * silu_(z[e]); ss += t * t; v[e] = t * gnr[e]; }
          ss += __shfl_xor(ss, 1); ss += __shfl_xor(ss, 2); ss += __shfl_xor(ss, 4);
          if (xseg == 0) SSP[trow * 16 + h] = ss;
          *(u32x4*)(O0 + trow * 1024 + h * 64 + xseg * 8) = pack8(v); }
    }
}
__device__ void item_rgscan(int tidv, KP P, LAS unsigned char* lds, int b, int hb) {
    unsigned char* ws = P->ws; const int tid = tidv, cg8 = tid & 7, tc = tid >> 3;
    const bf16_t* LA = (const bf16_t*)(ws + T_LA); const bf16_t* UU = (const bf16_t*)(ws + T_UU); const bf16_t* PROJ = (const bf16_t*)(ws + OFF_BIG); bf16_t* O3 = (bf16_t*)(ws + O_O) + (size_t)3 * T_ * 1024;
    LAS float* sA = (LAS float*)lds; LAS float* sH = sA + 64 * 72;
    const int ch = hb * 64 + cg8 * 8; const size_t r0 = (size_t)b * 2048 + tc * 32;
    float A[8], hh[8];
#pragma unroll
    for (int e = 0; e < 8; ++e) { A[e] = 1.f; hh[e] = 0.f; }
#pragma unroll 4
    for (int t = 0; t < 32; ++t) { float la[8], u[8]; unpack8(*(const u32x4*)(LA + (r0 + t) * 1024 + ch), la); unpack8(*(const u32x4*)(UU + (r0 + t) * 1024 + ch), u);
#pragma unroll
        for (int e = 0; e < 8; ++e) { const float a = __expf(la[e]); hh[e] = a * hh[e] + u[e]; A[e] *= a; } }
#pragma unroll
    for (int e = 0; e < 8; ++e) { sA[tc * 72 + cg8 * 8 + e] = A[e]; sH[tc * 72 + cg8 * 8 + e] = hh[e]; }
    __syncthreads();
    float hc[8];
#pragma unroll
    for (int e = 0; e < 8; ++e) hc[e] = 0.f;
    for (int c = 0; c < tc; ++c) {
#pragma unroll
        for (int e = 0; e < 8; ++e) hc[e] = sA[c * 72 + cg8 * 8 + e] * hc[e] + sH[c * 72 + cg8 * 8 + e]; }
#pragma unroll 4
    for (int t = 0; t < 32; ++t) { float la[8], u[8], gt[8], o[8]; unpack8(*(const u32x4*)(LA + (r0 + t) * 1024 + ch), la); unpack8(*(const u32x4*)(UU + (r0 + t) * 1024 + ch), u);
        unpack8(*(const u32x4*)(PROJ + (r0 + t) * LDP + D_GATE + ch), gt);
#pragma unroll
        for (int e = 0; e < 8; ++e) { const float a = __expf(la[e]); hc[e] = a * hc[e] + u[e]; o[e] = hc[e] * gelu_t(gt[e]); }
        *(u32x4*)(O3 + (r0 + t) * 1024 + ch) = pack8(o); }
}
__device__ void item_cmp2(int tidv, KP P, int L, int it, unsigned* done) {
    unsigned char* ws = P->ws; const int tid = tidv; const bf16_t* HID = (const bf16_t*)(ws + T_HID); bf16_t* dst = (bf16_t*)(ws + T_KC2);
    const int r0 = it * 64, sub = r0 >= 4096; const float* w2 = (sub ? P->in[21] : P->in[19]) + (size_t)L * 256 * 64;
    const int d = tid & 63, rr = tid >> 6; float acc[8];
#pragma unroll
    for (int q = 0; q < 8; ++q) acc[q] = 0.f;
    for (int j0 = 0; j0 < 256; j0 += 8) { float wv[8];
#pragma unroll
        for (int e = 0; e < 8; ++e) wv[e] = w2[(j0 + e) * 64 + d];
#pragma unroll
        for (int q = 0; q < 8; ++q) { float hv[8]; unpack8(*(const u32x4*)(HID + (size_t)(r0 + rr * 8 + q) * 256 + j0), hv);
#pragma unroll
            for (int e = 0; e < 8; ++e) acc[q] += hv[e] * wv[e]; } }
#pragma unroll
    for (int q = 0; q < 8; ++q) dst[(size_t)(r0 + rr * 8 + q) * 64 + d] = f2bf(acc[q]);
    asm volatile("s_waitcnt vmcnt(0)" ::: "memory"); __syncthreads();
    if (tid == 0) { __builtin_amdgcn_fence(__ATOMIC_RELEASE, "agent"); asm volatile("s_waitcnt vmcnt(0)" ::: "memory"); __hip_atomic_fetch_add(done, 1u, __ATOMIC_RELAXED, __HIP_MEMORY_SCOPE_AGENT); }
}
__device__ __forceinline__ bf16x8 pack_p(const f32x4& a, const f32x4& b) { u32x4 w; w.x = pk2(a[0], a[1]); w.y = pk2(a[2], a[3]); w.z = pk2(b[0], b[1]); w.w = pk2(b[2], b[3]); return __builtin_bit_cast(bf16x8, w); }
template <int DV, int VLD, bool MASKED, bool SHAREK, class MF>
__device__ __forceinline__ void attn_tile2(const LAS bf16_t* Ks, const LAS bf16_t* Vs, const bf16x8 (&qf)[2][2], f32x4 (&o)[2][DV / 16], f32x4 (&lacc)[2], float (&m)[2], int li, int lg, const MF& valid) {
    f32x4 s[2][4];
    if (SHAREK) {
#pragma unroll
        for (int kt = 0; kt < 4; ++kt) { s[0][kt] = (f32x4){0.f, 0.f, 0.f, 0.f}; s[1][kt] = (f32x4){0.f, 0.f, 0.f, 0.f};
#pragma unroll
            for (int ks = 0; ks < 2; ++ks) { const bf16x8 k0 = *(const LAS bf16x8*)(Ks + (kt * 16 + li) * 72 + ks * 32 + lg * 8);
                s[0][kt] = __builtin_amdgcn_mfma_f32_16x16x32_bf16(k0, qf[0][ks], s[0][kt], 0, 0, 0); s[1][kt] = __builtin_amdgcn_mfma_f32_16x16x32_bf16(k0, qf[1][ks], s[1][kt], 0, 0, 0); }
            __builtin_amdgcn_sched_barrier(0); } }
    bf16x8 pf[2][2];
#pragma unroll
    for (int g = 0; g < 2; ++g) {
        if (!SHAREK) {
#pragma unroll
            for (int kt = 0; kt < 4; ++kt) { s[g][kt] = (f32x4){0.f, 0.f, 0.f, 0.f};
#pragma unroll
                for (int ks = 0; ks < 2; ++ks) { const bf16x8 kf = *(const LAS bf16x8*)(Ks + g * 64 * 72 + (kt * 16 + li) * 72 + ks * 32 + lg * 8); s[g][kt] = __builtin_amdgcn_mfma_f32_16x16x32_bf16(kf, qf[g][ks], s[g][kt], 0, 0, 0); }
                if (kt & 1) __builtin_amdgcn_sched_barrier(0); } }
        float mx = -1e30f;
#pragma unroll
        for (int kt = 0; kt < 4; ++kt)
#pragma unroll
            for (int j = 0; j < 4; ++j) { float sv = s[g][kt][j]; if (MASKED) { sv = valid(kt * 16 + lg * 4 + j) ? sv : -1e30f; s[g][kt][j] = sv; } mx = fmaxf(mx, sv); }
        mx = rmax4(mx);
        if (!__all(mx <= m[g])) { const float mn = fmaxf(m[g], mx), alpha = __builtin_amdgcn_exp2f((m[g] - mn) * LOG2E); m[g] = mn; lacc[g] *= alpha;
#pragma unroll
            for (int mt = 0; mt < DV / 16; ++mt) o[g][mt] *= alpha; }
        const float nm = -m[g] * LOG2E;
#pragma unroll
        for (int kt = 0; kt < 4; ++kt)
#pragma unroll
            for (int j = 0; j < 4; ++j) { float pv = __builtin_amdgcn_exp2f(fmaf(s[g][kt][j], LOG2E, nm)); if (MASKED) pv = (s[g][kt][j] > -1e29f) ? pv : 0.f; s[g][kt][j] = pv; }
        pf[g][0] = pack_p(s[g][0], s[g][1]); pf[g][1] = pack_p(s[g][2], s[g][3]);
        __builtin_amdgcn_sched_barrier(0);
    }
    bf16x8 ones;
#pragma unroll
    for (int i = 0; i < 8; ++i) ones[i] = (short)0x3F80;
#pragma unroll
    for (int kp = 0; kp < 2; ++kp) {
        lacc[0] = __builtin_amdgcn_mfma_f32_16x16x32_bf16(ones, pf[0][kp], lacc[0], 0, 0, 0); lacc[1] = __builtin_amdgcn_mfma_f32_16x16x32_bf16(ones, pf[1][kp], lacc[1], 0, 0, 0);
#pragma unroll
        for (int mt = 0; mt < DV / 16; ++mt) {
            const s16x4 v0 = tr_read(Vs + ((2 * kp) * 16 + lg * 4 + (li >> 2)) * VLD + mt * 16 + (li & 3) * 4);
            const s16x4 v1 = tr_read(Vs + ((2 * kp + 1) * 16 + lg * 4 + (li >> 2)) * VLD + mt * 16 + (li & 3) * 4);
            bf16x8 vf; vf[0] = v0[0]; vf[1] = v0[1]; vf[2] = v0[2]; vf[3] = v0[3]; vf[4] = v1[0]; vf[5] = v1[1]; vf[6] = v1[2]; vf[7] = v1[3];
            o[0][mt] = __builtin_amdgcn_mfma_f32_16x16x32_bf16(vf, pf[0][kp], o[0][mt], 0, 0, 0); o[1][mt] = __builtin_amdgcn_mfma_f32_16x16x32_bf16(vf, pf[1][kp], o[1][mt], 0, 0, 0);
            if (mt & 1) __builtin_amdgcn_sched_barrier(0);
        }
    }
}
__device__ void item_diff(int tidv, KP P, int L, LAS unsigned char* lds, int b, int h, int qb) {
    unsigned char* ws = P->ws; const int tid = tidv, lane = tid & 63, w = tid >> 6, li = lane & 15, lg = lane >> 4;
    const bf16_t* PROJ = (const bf16_t*)(ws + OFF_BIG); bf16_t* O1 = (bf16_t*)(ws + O_O) + (size_t)1 * T_ * 1024;
    constexpr int BUFB = 35840;
    const int qpos = qb * 128 + w * 16 + li, qmaxw = qb * 128 + w * 16 + 15; const size_t trow = (size_t)b * 2048 + qpos;
    bf16x8 qf[2][2];
#pragma unroll
    for (int g = 0; g < 2; ++g)
#pragma unroll
        for (int ks = 0; ks < 2; ++ks) qf[g][ks] = *(const bf16x8*)(PROJ + trow * LDP + B_Q + h * 128 + g * 64 + ks * 32 + lg * 8);
    f32x4 o[2][8], lacc[2]; float m[2] = {-1e30f, -1e30f};
#pragma unroll
    for (int g = 0; g < 2; ++g) { lacc[g] = (f32x4){0.f, 0.f, 0.f, 0.f};
#pragma unroll
        for (int i = 0; i < 8; ++i) o[g][i] = (f32x4){0.f, 0.f, 0.f, 0.f}; }
    const int krr = (tid >> 3) & 63, ksg = tid & 7, vrr0 = tid >> 4, vsg = tid & 15;
    const bf16_t* gk = PROJ + ((size_t)b * 2048 + krr) * LDP + B_K + h * 128 + ksg * 8;
    const bf16_t* gv = PROJ + ((size_t)b * 2048 + vrr0) * LDP + B_V + h * 128 + vsg * 8;
    const int lk = (krr * 72 + ksg * 8) * 2, lv = 18432 + (vrr0 * 136 + vsg * 8) * 2;
    u32x4 r0, r1, r2, r3;
    { r0 = *(const u32x4*)gk; r1 = *(const u32x4*)(gk + 64); r2 = *(const u32x4*)gv; r3 = *(const u32x4*)(gv + (size_t)32 * LDP); }
    __syncthreads();
    { *(LAS u32x4*)(lds + lk) = r0; *(LAS u32x4*)(lds + 9216 + lk) = r1; *(LAS u32x4*)(lds + lv) = r2; *(LAS u32x4*)(lds + lv + 32 * 272) = r3; }
    __syncthreads();
    const int nkt = 2 * qb + 2;
    for (int kt = 0; kt < nkt; ++kt) {
        const int cur = kt & 1; const bool more = kt + 1 < nkt;
        if (more) { const size_t go = (size_t)(kt + 1) * 64 * LDP; r0 = *(const u32x4*)(gk + go); r1 = *(const u32x4*)(gk + go + 64); r2 = *(const u32x4*)(gv + go); r3 = *(const u32x4*)(gv + go + (size_t)32 * LDP); }
        const LAS bf16_t* Ks = (const LAS bf16_t*)(lds + cur * BUFB); const LAS bf16_t* Vs = (const LAS bf16_t*)(lds + cur * BUFB + 18432);
        const int k0 = kt * 64;
        if (k0 <= qmaxw) {
            if (__all(k0 + 63 <= qpos)) attn_tile2<128, 136, false, false>(Ks, Vs, qf, o, lacc, m, li, lg, [=](int) { return true; });
            else attn_tile2<128, 136, true, false>(Ks, Vs, qf, o, lacc, m, li, lg, [=](int ko) { return k0 + ko <= qpos; }); }
        if (more) { LAS unsigned char* nb = lds + (cur ^ 1) * BUFB; *(LAS u32x4*)(nb + lk) = r0; *(LAS u32x4*)(nb + 9216 + lk) = r1; *(LAS u32x4*)(nb + lv) = r2; *(LAS u32x4*)(nb + lv + 32 * 272) = r3; }
        __syncthreads();
    }
    const float linit = L == 0 ? 0.2f : 0.35550906759f; const float lam = *(const float*)(ws + PS_LAM);
    const float i0 = 1.f / fmaxf(lacc[0][0], 1e-30f), i1 = lam / fmaxf(lacc[1][0], 1e-30f);
    float ss = 0.f;
#pragma unroll
    for (int mt = 0; mt < 8; ++mt) { o[0][mt] = o[0][mt] * i0 - o[1][mt] * i1; ss += o[0][mt][0] * o[0][mt][0] + o[0][mt][1] * o[0][mt][1] + o[0][mt][2] * o[0][mt][2] + o[0][mt][3] * o[0][mt][3]; }
    ss = lsum4(ss); const float rs = rsqrtf(ss * (1.f / 128.f) + 1e-6f) * (1.f - linit);
    const float* gn = P->in[16] + L * 128;
#pragma unroll
    for (int mt = 0; mt < 8; ++mt) { const f32x4 gg = *(const f32x4*)(gn + mt * 16 + lg * 4); u32x2 wv; wv.x = pk2(o[0][mt][0] * rs * gg[0], o[0][mt][1] * rs * gg[1]); wv.y = pk2(o[0][mt][2] * rs * gg[2], o[0][mt][3] * rs * gg[3]);
        *(u32x2*)(O1 + trow * 1024 + h * 128 + mt * 16 + lg * 4) = wv; }
}
template <int MODE>
__device__ __forceinline__ void nsa_branch(int tid, const bf16_t* PROJ, LAS unsigned char* lds, int b, int g, int qpos, const bf16x8 (&qf)[2][2], unsigned selm, unsigned rem, const bf16_t* gptr, u32x2 (&acc)[2][4]) {
    const int lane = tid & 63, li = lane & 15, lg = lane >> 4;
    constexpr int BUFB = 18432;
    f32x4 o[2][4], lacc[2]; float m[2] = {-1e30f, -1e30f};
#pragma unroll
    for (int q = 0; q < 2; ++q) { lacc[q] = (f32x4){0.f, 0.f, 0.f, 0.f};
#pragma unroll
        for (int i = 0; i < 4; ++i) o[q][i] = (f32x4){0.f, 0.f, 0.f, 0.f}; }
    const int rr = tid >> 3, sg = tid & 7;
    const bf16_t* gk = PROJ + ((size_t)b * 2048 + rr) * LDP + (MODE == 0 ? C_KW : C_KS) + g * 64 + sg * 8;
    const bf16_t* gv = PROJ + ((size_t)b * 2048 + rr) * LDP + (MODE == 0 ? C_VW : C_VS) + g * 64 + sg * 8;
    const int lo = (rr * 72 + sg * 8) * 2;
    u32x4 r0, r1;
    int kt = __builtin_ctz(rem); rem &= rem - 1;
    { const size_t go = (size_t)kt * 64 * LDP; r0 = *(const u32x4*)(gk + go); r1 = *(const u32x4*)(gv + go); }
    __syncthreads();
    { *(LAS u32x4*)(lds + lo) = r0; *(LAS u32x4*)(lds + 9216 + lo) = r1; }
    __syncthreads();
    int cur = 0;
    for (;;) {
        const bool more = rem != 0u; int nkt = 0;
        if (more) { nkt = __builtin_ctz(rem); rem &= rem - 1; const size_t go = (size_t)nkt * 64 * LDP; r0 = *(const u32x4*)(gk + go); r1 = *(const u32x4*)(gv + go); }
        const LAS bf16_t* Ks = (const LAS bf16_t*)(lds + cur * BUFB); const LAS bf16_t* Vs = (const LAS bf16_t*)(lds + cur * BUFB + 9216);
        const int k0 = kt * 64;
        if (MODE == 0) {
            if (__all(k0 + 63 <= qpos && k0 > qpos - 512)) attn_tile2<64, 72, false, true>(Ks, Vs, qf, o, lacc, m, li, lg, [=](int) { return true; });
            else if (__any(k0 <= qpos && k0 + 63 > qpos - 512)) attn_tile2<64, 72, true, true>(Ks, Vs, qf, o, lacc, m, li, lg, [=](int ko) { const int kp = k0 + ko; return kp <= qpos && kp > qpos - 512; });
        } else { const bool sel = (selm >> kt) & 1u;
            if (__all(sel && k0 + 63 <= qpos)) attn_tile2<64, 72, false, true>(Ks, Vs, qf, o, lacc, m, li, lg, [=](int) { return true; });
            else if (__any(sel && k0 <= qpos)) attn_tile2<64, 72, true, true>(Ks, Vs, qf, o, lacc, m, li, lg, [=](int ko) { return sel && (k0 + ko <= qpos); }); }
        if (more) { LAS unsigned char* nb = lds + (cur ^ 1) * BUFB; *(LAS u32x4*)(nb + lo) = r0; *(LAS u32x4*)(nb + 9216 + lo) = r1; }
        __syncthreads();
        if (!more) break;
        kt = nkt; cur ^= 1;
    }
#pragma unroll
    for (int q = 0; q < 2; ++q) { const float inv = sigm(bf2f(gptr[q * 3])) / fmaxf(lacc[q][0], 1e-30f);
#pragma unroll
        for (int mt = 0; mt < 4; ++mt) { const f32x4 v = o[q][mt] * inv; const u32x2 pa = acc[q][mt];
            u32x2 w; w.x = pk2(v[0] + bf2f((bf16_t)(pa.x & 0xffff)), v[1] + bf2f((bf16_t)(pa.x >> 16))); w.y = pk2(v[2] + bf2f((bf16_t)(pa.y & 0xffff)), v[3] + bf2f((bf16_t)(pa.y >> 16))); acc[q][mt] = w; } }
}
__device__ void item_nsa(int tidv, KP P, int L, LAS unsigned char* lds, int bg, int pb, unsigned* done) {
    unsigned char* ws = P->ws; const int tid = tidv, lane = tid & 63, w = tid >> 6, li = lane & 15, lg = lane >> 4;
    const bf16_t* PROJ = (const bf16_t*)(ws + OFF_BIG); bf16_t* O2 = (bf16_t*)(ws + O_O) + (size_t)2 * T_ * 1024;
    const bf16_t* KC2 = (const bf16_t*)(ws + T_KC2) + (size_t)bg * 128 * 64; const bf16_t* VC2 = (const bf16_t*)(ws + T_VC2) + (size_t)bg * 128 * 64;
    LAS float* impA = (LAS float*)(lds + 40960); LAS float* impB = impA + 4 * 64 * 33; LAS float* impF = impB + 4 * 64 * 33; LAS unsigned* selb = (LAS unsigned*)(impF + 64 * 33);
    const int b = bg >> 2, g = bg & 3, hp = w >> 2, p0 = pb * 64, pl = (w & 3) * 16 + li, qpos = p0 + pl; const size_t trow = (size_t)b * 2048 + qpos;
    bf16x8 qf[2][2];
#pragma unroll
    for (int q = 0; q < 2; ++q) { const int hd = g * 4 + 2 * hp + q;
#pragma unroll
        for (int ks = 0; ks < 2; ++ks) qf[q][ks] = *(const bf16x8*)(PROJ + trow * LDP + C_Q + hd * 64 + ks * 32 + lg * 8);
 }
    u32x2 acc[2][4];
#pragma unroll
    for (int q = 0; q < 2; ++q)
#pragma unroll
        for (int i = 0; i < 4; ++i) acc[q][i] = (u32x2){0u, 0u};
    const bf16_t* gbase = PROJ + trow * LDP + C_G + (g * 4 + 2 * hp) * 3;
    const int thi = pb;
    { const int tlo = (p0 - 511) > 0 ? ((p0 - 511) >> 6) : 0; const unsigned rem = ((2u << thi) - 1u) & ~((1u << tlo) - 1u);
      nsa_branch<0>(tid, PROJ, lds, b, g, qpos, qf, 0u, rem, gbase + 2, acc); }
    if (tid == 0) { LAS int* cflag = (LAS int*)(lds + LDS_MISC + 96);
        if (*cflag == 0) { while (__hip_atomic_load(done, __ATOMIC_RELAXED, __HIP_MEMORY_SCOPE_AGENT) < 128u) __builtin_amdgcn_s_sleep(8);
            __builtin_amdgcn_fence(__ATOMIC_ACQUIRE, "agent"); asm volatile("s_waitcnt vmcnt(0)" ::: "memory"); *cflag = 1; } }
    __syncthreads();
    { LAS bf16_t* Ks = (LAS bf16_t*)lds; LAS bf16_t* Vs = Ks + 128 * 72;
      stage_rows(tidv, Ks, 72, KC2, 64, 128, 64); stage_rows(tidv, Vs, 72, VC2, 64, 128, 64);
      __syncthreads();
#pragma unroll
      for (int q = 0; q < 2; ++q) {
          f32x4 s0[4], s1[4]; qk_tile(Ks, qf[q], s0, li, lg); __builtin_amdgcn_sched_barrier(0); qk_tile(Ks + 64 * 72, qf[q], s1, li, lg); __builtin_amdgcn_sched_barrier(0);
          float mx = -1e30f;
#pragma unroll
          for (int kt = 0; kt < 4; ++kt)
#pragma unroll
              for (int jj = 0; jj < 4; ++jj) { const int n0 = kt * 16 + lg * 4 + jj, n1 = 64 + n0;
                  const float a = (16 * n0 + 31 <= qpos) ? s0[kt][jj] * LOG2E : -1e30f, c = (16 * n1 + 31 <= qpos) ? s1[kt][jj] * LOG2E : -1e30f; s0[kt][jj] = a; s1[kt][jj] = c; mx = fmaxf(mx, fmaxf(a, c)); }
          mx = rmax4(mx);
          float ps = 0.f;
#pragma unroll
          for (int kt = 0; kt < 4; ++kt)
#pragma unroll
              for (int jj = 0; jj < 4; ++jj) { const float a = s0[kt][jj] > -1e29f ? __builtin_amdgcn_exp2f(s0[kt][jj] - mx) : 0.f, c = s1[kt][jj] > -1e29f ? __builtin_amdgcn_exp2f(s1[kt][jj] - mx) : 0.f; s0[kt][jj] = a; s1[kt][jj] = c; ps += a + c; }
          ps = lsum4(ps); const float inv = 1.f / fmaxf(ps, 1e-30f);
#pragma unroll
          for (int kt = 0; kt < 4; ++kt) { s0[kt] *= inv; s1[kt] *= inv; }
          f32x4 o[4];
#pragma unroll
          for (int i = 0; i < 4; ++i) o[i] = (f32x4){0.f, 0.f, 0.f, 0.f};
          __builtin_amdgcn_sched_barrier(0);
          pv_tile<64, 72>(Vs, s0, o, li, lg); __builtin_amdgcn_sched_barrier(0); pv_tile<64, 72>(Vs + 64 * 72, s1, o, li, lg);
          __builtin_amdgcn_sched_barrier(0);
          { const float gc = sigm(bf2f(gbase[q * 3]));
#pragma unroll
            for (int i = 0; i < 4; ++i) { const f32x4 v = o[i] * gc; const u32x2 pa = acc[q][i];
                u32x2 w; w.x = pk2(v[0] + bf2f((bf16_t)(pa.x & 0xffff)), v[1] + bf2f((bf16_t)(pa.x >> 16))); w.y = pk2(v[2] + bf2f((bf16_t)(pa.y & 0xffff)), v[3] + bf2f((bf16_t)(pa.y >> 16))); acc[q][i] = w; } }
          LAS float* ia = impA + ((2 * hp + q) * 64 + pl) * 33; LAS float* ib = impB + ((2 * hp + q) * 64 + pl) * 33;
#pragma unroll
          for (int kt = 0; kt < 4; ++kt) { const int m0 = kt * 4 + lg, m1 = 16 + m0;
              ia[m0] = s0[kt][0] + s0[kt][1] + s0[kt][2] + 0.5f * s0[kt][3]; ib[m0 + 1] = 0.5f * s0[kt][3];
              ia[m1] = s1[kt][0] + s1[kt][1] + s1[kt][2] + 0.5f * s1[kt][3]; ib[m1 + 1] = 0.5f * s1[kt][3]; }
          if (lg == 0) ib[0] = 0.f;
          __builtin_amdgcn_sched_barrier(0); } }
    __syncthreads();
#pragma unroll
    for (int k = 0; k < 4; ++k) { const int idx = tid + 512 * k, pos = idx >> 5, mm = idx & 31; float v = 0.f;
#pragma unroll
        for (int jj = 0; jj < 4; ++jj) v += impA[(jj * 64 + pos) * 33 + mm] + impB[(jj * 64 + pos) * 33 + mm];
        if (mm == 0 || mm == pb) v = 1e4f; else if (mm > pb) v = -1e30f; impF[pos * 33 + mm] = v; }
    if (tid < 64) selb[tid] = 0u;
    __syncthreads();
    { const int pos = tid >> 3; unsigned bits = 0;
#pragma unroll
      for (int k = 0; k < 4; ++k) { const int mm = (tid & 7) * 4 + k; const float v = impF[pos * 33 + mm]; int cnt = 0;
          for (int m2 = 0; m2 < 32; ++m2) { const float v2 = impF[pos * 33 + m2]; cnt += (v2 > v || (v2 == v && m2 < mm)) ? 1 : 0; }
          if (cnt < 8) bits |= 1u << mm; }
      if (bits) atomicOr((unsigned*)(selb + pos), bits); }
    __syncthreads();
    { const unsigned selm = selb[pl]; unsigned um = 0;
#pragma unroll 8
      for (int i = 0; i < 64; ++i) um |= selb[i];
      nsa_branch<1>(tid, PROJ, lds, b, g, qpos, qf, selm, um & ((2u << thi) - 1u), gbase + 1, acc); }
#pragma unroll
    for (int q = 0; q < 2; ++q) { const int hd = g * 4 + 2 * hp + q;
#pragma unroll
        for (int mt = 0; mt < 4; ++mt) *(u32x2*)(O2 + trow * 1024 + hd * 64 + mt * 16 + lg * 4) = acc[q][mt]; }
}
__device__ void phase_ffn_fix(int tidv, int bidv, KP P, int L) {
    unsigned char* ws = P->ws; const bf16_t* USIDE = (const bf16_t*)(ws + OFF_BIG); bf16_t* ACT = (bf16_t*)(ws + O_ACT);
    const float* cw = P->in[33] + (size_t)L * 3 * 12288; const float* cb = P->in[34] + (size_t)L * 12288;
    for (int it = bidv * 512 + tidv; it < 512 * 768; it += gridDim.x * 512) {
        const int ri = it / 768, c = (it - ri * 768) * 8, r = (ri >> 1) * 64 + (ri & 1), s = r & 2047;
        float ug[8], uv[8];
#pragma unroll
        for (int e = 0; e < 8; ++e) { ug[e] = cb[c + e]; uv[e] = cb[6144 + c + e]; }
#pragma unroll
        for (int k = 0; k < 3; ++k) if (s - 2 + k >= 0) { const int rp = r - 2 + k, m64 = rp & 63, slot = m64 >= 62 ? m64 - 60 : m64;
            const bf16_t* sp = USIDE + ((size_t)(rp >> 6) * 4 + slot) * 12288 + c; float a[8], d[8]; unpack8(*(const u32x4*)sp, a); unpack8(*(const u32x4*)(sp + 6144), d);
#pragma unroll
            for (int e = 0; e < 8; ++e) { ug[e] += cw[k * 12288 + c + e] * a[e]; uv[e] += cw[k * 12288 + 6144 + c + e] * d[e]; } }
        float o[8];
#pragma unroll
        for (int e = 0; e < 8; ++e) o[e] = gelu_t(ug[e]) * uv[e];
        *(u32x4*)(ACT + (size_t)r * 6144 + c) = pack8(o);
    }
}
__device__ void final_norm(int tidv, int bidv, KP P) {
    const int lane = tidv & 63, wv = tidv >> 6; const float* g = P->in[38];
    for (int row = (bidv * 8 + wv) * 2; row < T_; row += gridDim.x * 16) {
        float* xr = P->X + (size_t)row * 2048; f32x4 v[2][8]; float ss0 = 0.f, ss1 = 0.f;
#pragma unroll
        for (int i = 0; i < 8; ++i) { v[0][i] = *(const f32x4*)(xr + i * 256 + lane * 4); v[1][i] = *(const f32x4*)(xr + 2048 + i * 256 + lane * 4); }
#pragma unroll
        for (int i = 0; i < 8; ++i) { ss0 += v[0][i][0] * v[0][i][0] + v[0][i][1] * v[0][i][1] + v[0][i][2] * v[0][i][2] + v[0][i][3] * v[0][i][3];
                                      ss1 += v[1][i][0] * v[1][i][0] + v[1][i][1] * v[1][i][1] + v[1][i][2] * v[1][i][2] + v[1][i][3] * v[1][i][3]; }
#pragma unroll
        for (int o = 32; o >= 1; o >>= 1) { ss0 += __shfl_xor(ss0, o); ss1 += __shfl_xor(ss1, o); }
        const float rs0 = rsqrtf(ss0 * (1.0f / 2048.0f) + 1e-6f), rs1 = rsqrtf(ss1 * (1.0f / 2048.0f) + 1e-6f);
#pragma unroll
        for (int i = 0; i < 8; ++i) { const f32x4 gg = *(const f32x4*)(g + i * 256 + lane * 4); *(f32x4*)(xr + i * 256 + lane * 4) = v[0][i] * rs0 * gg; *(f32x4*)(xr + 2048 + i * 256 + lane * 4) = v[1][i] * rs1 * gg; }
    }
}

#ifdef ONLY_CASE
#define CASE_ON(n) (ONLY_CASE == n)
#else
#define CASE_ON(n) 1
#endif

#define XB_TMO      128
#define XB_XCNT(j)  (256  + 64 * (j))
#define XB_XSUB(j)  (1280 + 64 * (j))
#define XB_XGEN(j)  (2304 + 64 * (j))
#define XB_TOP      3328
#define XB_TOPGEN   3392
#define XCD_BAR_WORDS 3456
#define XB_SPIN_CAP (1u << 20)
__device__ __forceinline__ unsigned xb_ld(unsigned* p)              { return __hip_atomic_load(p, __ATOMIC_RELAXED, __HIP_MEMORY_SCOPE_AGENT); }
__device__ __forceinline__ unsigned xb_add(unsigned* p, unsigned v) { return __hip_atomic_fetch_add(p, v, __ATOMIC_RELAXED, __HIP_MEMORY_SCOPE_AGENT); }
__device__ __forceinline__ unsigned xb_xcc_id() { return (unsigned)__builtin_amdgcn_s_getreg((3 << 11) | 20) & 0xFu; }
#define XB_SPIN(cond, bar) do { unsigned _sp = 0; while (cond) { __builtin_amdgcn_s_sleep(1); \
    if ((++_sp & 255u) == 0u) { if (xb_ld(&(bar)[XB_TMO])) break; if (_sp > XB_SPIN_CAP) { atomicAdd(&(bar)[XB_TMO], 1u); break; } } } } while (0)
__device__ __forceinline__ void xcd_barrier_complete(unsigned* bar, unsigned x, unsigned& nloc, unsigned& nx) {
    const unsigned G = gridDim.x;
    unsigned sum, cnt, mine, sp = 0u;
    for (;;) {
        sum = 0u; cnt = 0u; mine = 0u;
#pragma unroll
        for (unsigned j = 0; j < 16; ++j) { const unsigned c = xb_ld(&bar[XB_XCNT(j)]); sum += c; cnt += (c > 0u) ? 1u : 0u; mine = (j == x) ? c : mine; }
        if (sum == G) break;
        __builtin_amdgcn_s_sleep(1);
        if ((++sp & 255u) == 0u) { if (xb_ld(&bar[XB_TMO])) break; if (sp > XB_SPIN_CAP) { atomicAdd(&bar[XB_TMO], 1u); break; } }
    }
    nloc = mine > 0u ? mine : 1u; nx = cnt > 0u ? cnt : 1u;
}
__device__ __forceinline__ void xcd_barrier(unsigned* bar, volatile LAS unsigned* st) {
    asm volatile("s_waitcnt vmcnt(0)" ::: "memory");
    __syncthreads();
    if (threadIdx.x == 0) {
        const unsigned x = xb_xcc_id();
        __builtin_amdgcn_s_waitcnt(0);
        unsigned nloc = st[0], nx = st[1];
        if (nloc == 0u) { xcd_barrier_complete(bar, x, nloc, nx); st[0] = nloc; st[1] = nx; }
        const unsigned old = xb_add(&bar[XB_XSUB(x)], 1u);
        const unsigned gen = old / nloc;
        if (old + 1u == (gen + 1u) * nloc) {
            __builtin_amdgcn_fence(__ATOMIC_RELEASE, "agent");
            asm volatile("s_waitcnt vmcnt(0)" ::: "memory");
            const unsigned og = xb_add(&bar[XB_TOP], 1u);
            const unsigned tg = og / nx;
            if (og + 1u == (tg + 1u) * nx) xb_add(&bar[XB_TOPGEN], 1u);
            else XB_SPIN(xb_ld(&bar[XB_TOPGEN]) == tg, bar);
            __builtin_amdgcn_fence(__ATOMIC_ACQUIRE, "agent");
            xb_add(&bar[XB_XGEN(x)], 1u);
            asm volatile("s_waitcnt vmcnt(0)" ::: "memory");
        } else {
            XB_SPIN(xb_ld(&bar[XB_XGEN(x)]) == gen, bar);
            __builtin_amdgcn_fence(__ATOMIC_ACQUIRE, "agent");
            asm volatile("s_waitcnt vmcnt(0)" ::: "memory");
        }
    }
    __syncthreads();
}

constexpr int PH_PER_LAYER = 16, N_PHASES = 2 * PH_PER_LAYER + 1;

__device__ void run_phase(int tidv, int bidv, KP P, int ph, LAS unsigned char* lds) {
    unsigned char* ws = P->ws;
    if (ph == 2 * PH_PER_LAYER) { final_norm(tidv, bidv, P); return; }
    const int L = ph / PH_PER_LAYER, k = ph % PH_PER_LAYER; const int G = gridDim.x, c = bidv;
    unsigned* ctr = (unsigned*)(ws + PS_CTR) + L * 4;
    pg8::Order S;
    switch (k) {
#if CASE_ON(0)
    case 0: phase_w_a(tidv, bidv, P, L, lds); break;
#endif
#if CASE_ON(1)
    case 1: { S.init(64, 41, 1, G, c, 0); pg8::gemm_phase<2048, 2048>(tidv, bidv, lds, (const bf16_t*)(ws + OFF_H), (const bf16_t*)(ws + W_IN), S, EpiBf{(bf16_t*)(ws + OFF_BIG), LDP, 0x7fffffff, nullptr, nullptr}); } break;
#endif
#if CASE_ON(2)
    case 2: phase_prep(tidv, bidv, P, L); break;
#endif
#if CASE_ON(3)
    case 3: {
        if (c >= 32) {
            S.init(64, 8, 1, G - 32, c - 32, 1);
            pg8::gemm_phase<1024, 256>(tidv, bidv, lds, (const bf16_t*)(ws + T_XC), (const bf16_t*)(ws + W_RG), S,
                            EpiRG{(const bf16_t*)(ws + T_XC), P->in[25] + L * 1024, P->in[27] + L * 1024, (const float*)(ws + PS_SPL), (bf16_t*)(ws + T_LA), (bf16_t*)(ws + T_UU)});
        } else {
            S.init(16, 1, 2, 32, c, 0);
            pg8::gemm_phase<1024, 2048>(tidv, bidv, lds, (const bf16_t*)(ws + T_KCVC), (const bf16_t*)(ws + W_C1), S, EpiHid{(bf16_t*)(ws + T_HID), 256, 0, (const float*)(ws + PS_C1), nullptr});
        }
    } break;
#endif
#if CASE_ON(4)
    case 4: {
        { LAS int* cflag = (LAS int*)(lds + LDS_MISC + 96); if (tidv == 0) *cflag = 0; }
        int it = queue_pop(tidv, lds, ctr + 0);
        while (it < 384 + 2048) {
            unsigned nxt = 0u; if (tidv == 0) nxt = atomicAdd(ctr + 0, 1u);
#if PROBE_ITEM
            const unsigned long long q0 = wall_clock64();
#endif
            int tv = tidv; asm volatile("" : "+v"(tv)); KP Pq = P; asm volatile("" : "+s"(Pq)); int Lq = L; asm volatile("" : "+s"(Lq));
            int ty;
            if (it < 128) { ty = 3; item_cmp2(tv, Pq, Lq, it, ctr + 3); }
            else if (it < 256) { ty = 1; item_ssd(tv, Pq, Lq, lds, (it - 128) >> 4, (it - 128) & 15); }
            else if (it < 384) { ty = 2; item_rgscan(tv, Pq, lds, (it - 256) >> 4, (it - 256) & 15); }
            else if (it < 384 + 1024) { ty = 4; const int jx = it - 384; item_diff(tv, Pq, Lq, lds, (jx & 63) >> 3, jx & 7, 15 - (jx >> 6)); }
            else { ty = 5; const int jx = it - 384 - 1024; item_nsa(tv, Pq, Lq, lds, jx & 31, 31 - (jx >> 5), ctr + 3); }
#if PROBE_ITEM
            if (ty == PROBE_ITEM) { __syncthreads(); const unsigned long long q1 = wall_clock64(); while (wall_clock64() - q1 < q1 - q0) __builtin_amdgcn_s_sleep(8); }
#endif
            (void)ty;
            { LAS int* s_item = (LAS int*)(lds + LDS_MISC); __syncthreads(); if (tidv == 0) *s_item = (int)nxt; __syncthreads(); it = *s_item; } }
    } break;
#endif
#if CASE_ON(5)
    case 5: break;
#endif
#if CASE_ON(6)
    case 6: break;
#endif
#if CASE_ON(7)
    case 7: { S.init(64, 8, 4, G, c, 0);
        pg8::gemm_phase<1024, 1024>(tidv, bidv, lds, (const bf16_t*)(ws + O_O), (const bf16_t*)(ws + W_B), S, EpiBf{(bf16_t*)(ws + OFF_BIG), 2048, 7, nullptr, (const float*)(ws + T_SSP)});
        phase_w_b(tidv, bidv, P, L, lds); } break;
#endif
#if CASE_ON(8)
    case 8: { S.init(64, 32, 1, G, c, 0); pg8::gemm_phase<2048, 2048>(tidv, bidv, lds, (const bf16_t*)(ws + OFF_H), (const bf16_t*)(ws + W_G), S, EpiMerge{(const bf16_t*)(ws + OFF_BIG), (bf16_t*)(ws + O_MERGED)}); } break;
#endif
#if CASE_ON(9)
    case 9: { S.init(64, 8, 1, G, c, 0); pg8::gemm_phase<2048, 2048>(tidv, bidv, lds, (const bf16_t*)(ws + O_MERGED), (const bf16_t*)(ws + W_OUT), S, EpiResidT<false>{P->X, nullptr}); } break;
#endif
#if CASE_ON(10)
    case 10: rms_rows(tidv, bidv, P->X, P->in[3] + L * 2048, (bf16_t*)(ws + OFF_H), nullptr); break;
#endif
#if CASE_ON(11)
    case 11: { S.init(64, 48, 1, G, c, 0); pg8::gemm_phase<2048, 2048>(tidv, bidv, lds, (const bf16_t*)(ws + OFF_H), (const bf16_t*)(ws + W_UP), S, EpiFfn{(bf16_t*)(ws + O_ACT), (bf16_t*)(ws + OFF_BIG), P->in[33] + (size_t)L * 3 * 12288, P->in[34] + (size_t)L * 12288}); } break;
#endif
#if CASE_ON(12)
    case 12: { phase_ffn_fix(tidv, bidv, P, L);
        asm volatile("" : "+v"(tidv)); asm volatile("" : "+s"(bidv));
        S.init(64, 8, 1, G, c, 0); pg8::gemm_phase<256, 256>(tidv, bidv, lds, (const bf16_t*)(ws + W_PB), (const bf16_t*)(ws + W_PP), S, EpiBf{(bf16_t*)(ws + O_PP), 2048, 0x7fffffff, nullptr, nullptr}); } break;
#endif
#if CASE_ON(13)
    case 13: { S.init(64, 8, 1, G, c, 0); pg8::gemm_phase<6144, 6144>(tidv, bidv, lds, (const bf16_t*)(ws + O_ACT), (const bf16_t*)(ws + W_DN), S, EpiResidT<false>{P->X, nullptr}); } break;
#endif
#if CASE_ON(14)
    case 14: rms_rows(tidv, bidv, P->X, P->in[4] + L * 2048, (bf16_t*)(ws + OFF_H), nullptr); break;
#endif
#if CASE_ON(15)
    case 15: { S.init(64, 8, 1, G, c, 0); pg8::gemm_phase<2048, 2048>(tidv, bidv, lds, (const bf16_t*)(ws + OFF_H), (const bf16_t*)(ws + W_PG), S, EpiResidT<true>{P->X, (const bf16_t*)(ws + O_PP)}); } break;
#endif
    }
}

__global__ void __launch_bounds__(512, 2) hybrid_fwd(Params P, int ph_lo, int ph_hi) {
    extern __shared__ __attribute__((aligned(16))) unsigned char shm[];
    LAS unsigned char* lds = (LAS unsigned char*)shm;
    cg::grid_group grid = cg::this_grid();
    volatile LAS unsigned* xst = (volatile LAS unsigned*)(lds + LDS_MISC + 64);
    unsigned* xbar = (unsigned*)(P.ws + PS_BAR);
    if (threadIdx.x == 0) { xst[0] = 0u; xst[1] = 0u; (void)xb_add(&xbar[XB_XCNT(xb_xcc_id())], 1u); }
    __syncthreads();
    for (int ph = ph_lo; ph < ph_hi; ++ph) {
        { const int kk = ph % PH_PER_LAYER; if (ph < 2 * PH_PER_LAYER && (kk == 5 || kk == 6)) continue; }
        if (ph > ph_lo) { if (ph == ph_lo + 1) grid.sync(); else xcd_barrier(xbar, xst); }
#if PROBE_MASK
        const unsigned long long pt0 = wall_clock64();
#endif
        int tidv = threadIdx.x, bidv = blockIdx.x; asm volatile("" : "+v"(tidv)); asm volatile("" : "+s"(bidv));
        KP kp = (KP)__builtin_amdgcn_kernarg_segment_ptr(); asm volatile("" : "+s"(kp));
        run_phase(tidv, bidv, kp, ph, lds);
        __syncthreads();
#if PROBE_MASK
        if (ph < 2 * PH_PER_LAYER && ((PROBE_MASK >> (ph % PH_PER_LAYER)) & 1)) { const unsigned long long pt1 = wall_clock64(); while (wall_clock64() - pt1 < pt1 - pt0) __builtin_amdgcn_s_sleep(8); }
#endif
    }
}

extern "C" void kernel_launch(void* const* d_in, const int* in_sizes, int n_in, void* d_out, int out_size, void* d_ws, size_t ws_size, hipStream_t stream) {
    static int grid = 0;
    if (grid == 0) {
        int dev = 0, cus = 0, per_cu = 0;
        hipGetDevice(&dev); hipDeviceGetAttribute(&cus, hipDeviceAttributeMultiprocessorCount, dev);
        if (hipFuncSetAttribute((const void*)hybrid_fwd, hipFuncAttributeMaxDynamicSharedMemorySize, LDS_BYTES) != hipSuccess) { fprintf(stderr, "hipFuncSetAttribute failed\n"); grid = -1; return; }
        hipOccupancyMaxActiveBlocksPerMultiprocessor(&per_cu, (const void*)hybrid_fwd, 512, LDS_BYTES);
        if (per_cu < 1) per_cu = 1;
        grid = cus * per_cu; if (grid > 256) grid = 256;
        if (n_in != 39 || ws_size < WS_END) { fprintf(stderr, "kernel_launch: unexpected n_in %d / ws_size %zu (need %zu)\n", n_in, ws_size, (size_t)WS_END); grid = -1; return; }
    }
    if (grid < 0) return;
    if (hipMemsetAsync((char*)d_ws + PS_BAR, 0, XCD_BAR_WORDS * 4, stream) != hipSuccess) { fprintf(stderr, "memset failed\n"); return; }
    Params p{};
    for (int i = 0; i < 39; ++i) p.in[i] = (const float*)d_in[i];
    p.X = (float*)d_out; p.ws = (unsigned char*)d_ws;
#if ONE_LAUNCH
    int lo = 0, hi = N_PHASES;
    void* args[] = {&p, &lo, &hi};
    hipError_t e = hipLaunchCooperativeKernel((const void*)hybrid_fwd, dim3(grid), dim3(512), args, LDS_BYTES, stream);
    if (e != hipSuccess) fprintf(stderr, "cooperative launch failed: %s (grid %d)\n", hipGetErrorString(e), grid);
#else
    for (int ph = 0; ph < N_PHASES; ++ph) hipLaunchKernelGGL(hybrid_fwd, dim3(grid), dim3(512), LDS_BYTES, stream, p, ph, ph + 1);
#endif
}
```

```cpp
#include <hip/hip_runtime.h>
#include <hip/hip_cooperative_groups.h>
#include <cstdio>
namespace cg = cooperative_groups;

typedef unsigned short bf16_t;
typedef short bf16x8 __attribute__((ext_vector_type(8)));
typedef short s16x4 __attribute__((ext_vector_type(4)));
typedef float f32x4 __attribute__((ext_vector_type(4)));
typedef unsigned u32x4 __attribute__((ext_vector_type(4)));
typedef unsigned u32x2 __attribute__((ext_vector_type(2)));
#define LAS __attribute__((address_space(3)))

#ifndef PROBE_MASK
#define PROBE_MASK 0
#endif
#ifndef PROBE_ITEM
#define PROBE_ITEM 0
#endif
#ifndef ONE_LAUNCH
#define ONE_LAUNCH 1
#endif

constexpr int T_ = 16384, S_ = 2048, LDP = 10496;
constexpr int A_Z = 0, A_XBC = 1024, A_DT = 2560, B_Q = 2576, B_K = 3600, B_V = 4624, C_Q = 5648, C_KC = 6672, C_VC = 6928,
              C_KS = 7184, C_VS = 7440, C_KW = 7696, C_VW = 7952, C_G = 8208, D_GATE = 8256, D_X = 9280;
constexpr size_t MiB = 1u << 20;
constexpr size_t OFF_W = 0, OFF_H = 100 * MiB, OFF_O2 = 164 * MiB, OFF_BIG = 356 * MiB, OFF_TT = 684 * MiB, OFF_PS = 852 * MiB, WS_END = 853 * MiB;
constexpr size_t W_IN = OFF_W, W_G = W_IN + 41 * MiB, W_B = W_G + 32 * MiB, W_OUT = W_B + 16 * MiB, W_RG = W_OUT + 8 * MiB, W_C1 = W_RG + 1 * MiB;
constexpr size_t O_O = OFF_O2, O_MERGED = OFF_O2 + 128 * MiB, O_ACT = OFF_O2, O_PP = OFF_BIG + 32 * MiB;
constexpr size_t T_XBC = OFF_TT, T_XC = OFF_TT + 48 * MiB, T_KCVC = OFF_TT + 80 * MiB, T_LA = OFF_TT + 97 * MiB, T_UU = OFF_TT + 129 * MiB,
                 T_DT = OFF_TT + 161 * MiB, T_HID = OFF_TT + 162 * MiB, T_KC2 = OFF_TT + 166 * MiB, T_VC2 = T_KC2 + 512 * 1024, T_SSP = OFF_TT + 167 * MiB;
constexpr size_t W_UP = OFF_TT + 56 * MiB, W_DN = OFF_TT + 104 * MiB, W_PG = OFF_TT + 128 * MiB, W_PP = OFF_TT + 136 * MiB, W_PB = OFF_TT + 137 * MiB;
constexpr size_t PS_ROPE = OFF_PS, PS_SELM = OFF_PS + 512 * 1024, PS_C1 = OFF_PS + 768 * 1024, PS_CTR = OFF_PS + 800 * 1024, PS_SPL = OFF_PS + 804 * 1024, PS_BAR = OFF_PS + 816 * 1024, PS_LAM = OFF_PS + 812 * 1024;
constexpr int LDS_BYTES = 147456, LDS_MISC = 131072;

struct Params { const float* in[39]; float* X; unsigned char* ws; };
typedef const Params __attribute__((address_space(4)))* KP;

__device__ __forceinline__ float bf2f(bf16_t v) { return __uint_as_float(((unsigned)v) << 16); }
__device__ __forceinline__ bf16_t f2bf(float f) { unsigned u = __float_as_uint(f); u += 0x7FFFu + ((u >> 16) & 1u); return (bf16_t)(u >> 16); }
__device__ __forceinline__ unsigned pk2(float lo, float hi) { unsigned r; asm("v_cvt_pk_bf16_f32 %0, %1, %2" : "=v"(r) : "v"(lo), "v"(hi)); return r; }
__device__ __forceinline__ void unpack8(const u32x4 v, float (&f)[8]) {
    f[0] = bf2f((bf16_t)(v.x & 0xffff)); f[1] = bf2f((bf16_t)(v.x >> 16)); f[2] = bf2f((bf16_t)(v.y & 0xffff)); f[3] = bf2f((bf16_t)(v.y >> 16));
    f[4] = bf2f((bf16_t)(v.z & 0xffff)); f[5] = bf2f((bf16_t)(v.z >> 16)); f[6] = bf2f((bf16_t)(v.w & 0xffff)); f[7] = bf2f((bf16_t)(v.w >> 16)); }
__device__ __forceinline__ u32x4 pack8(const float (&f)[8]) { u32x4 w; w.x = pk2(f[0], f[1]); w.y = pk2(f[2], f[3]); w.z = pk2(f[4], f[5]); w.w = pk2(f[6], f[7]); return w; }
__device__ __forceinline__ float sigm(float x) { return __builtin_amdgcn_rcpf(1.f + __expf(-x)); }
__device__ __forceinline__ float gelu_t(float x) { float u = 1.5957691216f * (x + 0.044715f * x * x * x); return x * __builtin_amdgcn_rcpf(1.f + __expf(-u)); }
__device__ __forceinline__ float softplus_(float x) { return x > 20.f ? x : __logf(1.f + __expf(x)); }
__device__ __forceinline__ float silu_(float x) { return x * __builtin_amdgcn_rcpf(1.f + __expf(-x)); }

namespace pg8 {
constexpr int BM = 256, BK = 64, HALF = 128, HTB = HALF * BK * 2, NXCD = 8, WGM = 8;
__device__ __forceinline__ int lds_byte(int r, int c) { const int st = (r >> 4) * 2 + (c >> 5), rr = r & 15, cc = c & 31, ob = rr * 64 + cc * 2; return st * 1024 + (ob ^ (((ob >> 9) & 1) << 5)); }
__device__ __forceinline__ void stage_rc(int b, int& R, int& C) { const int st = b / 1024, sb = b % 1024, swz = sb ^ (((sb >> 9) & 1) << 5); R = (st >> 1) * 16 + swz / 64; C = (st & 1) * 32 + (swz % 64) / 2; }
__device__ __forceinline__ int perm32(int rho) { const int n = rho >> 4, i = rho & 15; return 8 * (i >> 2) + 4 * n + (i & 3); }
struct Unit { int pm, pn, ka; };
struct Gemm { const bf16_t* A; const bf16_t* Bt; int lda, K; };
struct Order {
    int nM, nN, nsub, G, c, kmode;
    __device__ void init(int nM_, int nN_, int nsub_, int G_, int c_, int kmode_) { nM = nM_; nN = nN_; nsub = nsub_; G = G_; c = c_; kmode = kmode_; }
    __device__ bool next(int i, Unit& u) const {
        const int nwg = nM * nN; const int L = i * G + c; if (L >= nwg * nsub) return false;
        const int sub = L / nwg; int wgid = L - sub * nwg;
        { const int q = nwg / NXCD, r = nwg % NXCD, xcd = wgid % NXCD, off = wgid / NXCD; wgid = (xcd < r ? xcd * (q + 1) : r * (q + 1) + (xcd - r) * q) + off; }
        const int nig = WGM * nN, gid = wgid / nig, fm = gid * WGM, gsz = (nM - fm) < WGM ? (nM - fm) : WGM;
        const int pm0 = fm + ((wgid % nig) % gsz), pn0 = (wgid % nig) / gsz;
        u.pm = __builtin_amdgcn_readfirstlane(sub * nM + pm0); u.pn = __builtin_amdgcn_readfirstlane(sub * nN + pn0); u.ka = __builtin_amdgcn_readfirstlane(kmode ? 256 * (pn0 >> 1) : 0); return true;
    }
};

template <int lda, int K, class Epi>
__device__ __forceinline__ void gemm_phase(int tidv, int bidv, LAS unsigned char* lds, const bf16_t* gA, const bf16_t* gBt, const Order& S, const Epi& E) {
    const int tid = tidv, wid = __builtin_amdgcn_readfirstlane(tid >> 6), lane = tid & 63, wr = wid >> 2, wc = wid & 3, fr = lane & 15, fq = lane >> 4;
    constexpr int nt = K / BK;
    unsigned voffA[2], voffB[2];
#pragma unroll
    for (int i = 0; i < 2; ++i) { int R, C; stage_rc(tid * 16 + i * 8192, R, C); const int Rb = Epi::PERM ? ((R & ~31) + perm32(R & 31)) : R;
        voffA[i] = (unsigned)(R * lda + C) * 2u; voffB[i] = (unsigned)(Rb * K + C) * 2u; }
    constexpr size_t kstep = (size_t)(BK * 2);
    constexpr size_t hstepA = (size_t)HALF * lda * 2, hstepB = (size_t)HALF * K * 2;
    constexpr size_t tstepA = 2 * hstepA, tstepB = 2 * hstepB;
    const unsigned ldsw = (unsigned)wid * 1024u;
    const int aoff = lds_byte(wr * 64 + fr, fq * 8), boff = lds_byte(wc * 32 + fr, fq * 8);
#define PG8_SA(b, h) (((b) * 2 + (h)) * HTB)
#define PG8_SB(b, h) ((4 + (b) * 2 + (h)) * HTB)
#define PG8_STAGE(bufoff, gbase, voff) do { _Pragma("unroll") for (int _i = 0; _i < 2; ++_i) \
        __builtin_amdgcn_global_load_lds((const unsigned*)((const char*)(gbase) + (voff)[_i]), (LAS unsigned*)(lds + (bufoff) + ldsw + _i * 8192), 16, 0, 0); } while (0)
#define PG8_LDA(dst, b, h) do { _Pragma("unroll") for (int m = 0; m < 4; ++m) _Pragma("unroll") for (int k = 0; k < 2; ++k) dst[m][k] = *(const LAS bf16x8*)(lds + PG8_SA(b, h) + aoff + m * 2048 + k * 1024); } while (0)
#define PG8_LDB(dst, b, h) do { _Pragma("unroll") for (int n = 0; n < 2; ++n) _Pragma("unroll") for (int k = 0; k < 2; ++k) dst[n][k] = *(const LAS bf16x8*)(lds + PG8_SB(b, h) + boff + n * 2048 + k * 1024); } while (0)
#define PG8_MMA(ai, bj, At, Bt) do { __builtin_amdgcn_s_setprio(1); _Pragma("unroll") for (int m = 0; m < 4; ++m) _Pragma("unroll") for (int n = 0; n < 2; ++n) _Pragma("unroll") for (int k = 0; k < 2; ++k) \
        acc[ai][bj][m][n] = __builtin_amdgcn_mfma_f32_16x16x32_bf16(Bt[n][k], At[m][k], acc[ai][bj][m][n], 0, 0, 0); __builtin_amdgcn_s_setprio(0); } while (0)
#define PG8_WAIT_V(n) asm volatile("s_waitcnt vmcnt(" #n ")" ::: "memory")
#define PG8_WAIT_L(n) asm volatile("s_waitcnt lgkmcnt(" #n ")" ::: "memory")
#define PG8_BAR __builtin_amdgcn_s_barrier()
#define PG8_SCHED __builtin_amdgcn_sched_barrier(0)
    Unit cur, nxt; int ui = 0;
    if (!S.next(0, cur)) return;
    f32x4 acc[2][2][4][2];
#pragma unroll
    for (int a = 0; a < 2; ++a)
#pragma unroll
        for (int b = 0; b < 2; ++b)
#pragma unroll
            for (int m = 0; m < 4; ++m)
#pragma unroll
                for (int n = 0; n < 2; ++n) acc[a][b][m][n] = (f32x4){0.f, 0.f, 0.f, 0.f};
    bf16x8 At[4][2], B0[2][2], B1[2][2];
    const char* cA = (const char*)gA + (size_t)cur.pm * tstepA + (size_t)cur.ka * 2; const char* cB = (const char*)gBt + (size_t)cur.pn * tstepB;
    PG8_STAGE(PG8_SB(0, 0), cB, voffB); PG8_STAGE(PG8_SA(0, 0), cA, voffA); PG8_STAGE(PG8_SB(0, 1), cB + hstepB, voffB); PG8_STAGE(PG8_SA(0, 1), cA + hstepA, voffA);
    if (wr == 1) PG8_BAR;
    PG8_WAIT_V(4); PG8_BAR;
    PG8_STAGE(PG8_SB(1, 0), cB + kstep, voffB); PG8_STAGE(PG8_SA(1, 0), cA + kstep, voffA); PG8_STAGE(PG8_SB(1, 1), cB + hstepB + kstep, voffB);
    PG8_WAIT_V(6); PG8_BAR;
    for (;;) {
        const bool has_next = S.next(ui + 1, nxt);
        const char* nA = has_next ? (const char*)gA + (size_t)nxt.pm * tstepA + (size_t)nxt.ka * 2 : cA; const char* nB = has_next ? (const char*)gBt + (size_t)nxt.pn * tstepB : cB;
#pragma unroll 1
        for (int t = 0; t < nt; t += 2) {
            const bool last = (t == nt - 2);
            const char* a1 = cA + (size_t)(t + 1) * kstep;
            const char* a2 = last ? nA : cA + (size_t)(t + 2) * kstep; const char* b2 = last ? nB : cB + (size_t)(t + 2) * kstep;
            const char* a3 = a2 + kstep; const char* b3 = b2 + kstep;
            PG8_LDB(B0, 0, 0); PG8_SCHED; PG8_LDA(At, 0, 0); PG8_STAGE(PG8_SA(1, 1), a1 + hstepA, voffA);
            PG8_WAIT_L(8); PG8_BAR; PG8_WAIT_L(0); PG8_MMA(0, 0, At, B0); PG8_BAR; PG8_SCHED;
            PG8_LDB(B1, 0, 1); PG8_STAGE(PG8_SB(0, 0), b2, voffB);
            PG8_BAR; PG8_WAIT_L(0); PG8_MMA(0, 1, At, B1); PG8_BAR;
            PG8_LDA(At, 0, 1); PG8_STAGE(PG8_SA(0, 0), a2, voffA);
            PG8_BAR; PG8_WAIT_L(0); PG8_MMA(1, 0, At, B0); PG8_BAR; PG8_SCHED;
            PG8_STAGE(PG8_SB(0, 1), b2 + hstepB, voffB);
            PG8_WAIT_V(6); PG8_BAR; PG8_MMA(1, 1, At, B1); PG8_BAR;
            PG8_LDB(B0, 1, 0); PG8_SCHED; PG8_LDA(At, 1, 0); PG8_STAGE(PG8_SA(0, 1), a2 + hstepA, voffA);
            PG8_WAIT_L(8); PG8_BAR; PG8_WAIT_L(0); PG8_MMA(0, 0, At, B0); PG8_BAR; PG8_SCHED;
            PG8_LDB(B1, 1, 1); PG8_STAGE(PG8_SB(1, 0), b3, voffB);
            PG8_BAR; PG8_WAIT_L(0); PG8_MMA(0, 1, At, B1); PG8_BAR;
            PG8_LDA(At, 1, 1); PG8_STAGE(PG8_SA(1, 0), a3, voffA);
            PG8_BAR; PG8_WAIT_L(0); PG8_MMA(1, 0, At, B0); PG8_BAR; PG8_SCHED;
            PG8_STAGE(PG8_SB(1, 1), b3 + hstepB, voffB);
            PG8_WAIT_V(6); PG8_BAR; PG8_MMA(1, 1, At, B1); PG8_BAR;
        }
        E(acc, cur, wr, wc, fr, fq);
        if (!has_next) break;
#pragma unroll
        for (int a = 0; a < 2; ++a)
#pragma unroll
            for (int b = 0; b < 2; ++b)
#pragma unroll
                for (int m = 0; m < 4; ++m)
#pragma unroll
                    for (int n = 0; n < 2; ++n) acc[a][b][m][n] = (f32x4){0.f, 0.f, 0.f, 0.f};
        cur = nxt; cA = nA; cB = nB; ++ui;
    }
    PG8_WAIT_V(0);
    if (wr == 0) PG8_BAR;
    PG8_BAR;
#undef PG8_SA
#undef PG8_SB
#undef PG8_STAGE
#undef PG8_LDA
#undef PG8_LDB
#undef PG8_MMA
#undef PG8_WAIT_V
#undef PG8_WAIT_L
#undef PG8_BAR
#undef PG8_SCHED
}
}
using pg8::Unit;

template <bool HIDM> struct EpiBfT {
    static constexpr bool PERM = true;
    bf16_t* O; int ldc; int pnmask; const float* bias; const float* ssp;
    __device__ __forceinline__ void operator()(const f32x4 (&acc)[2][2][4][2], const Unit& u, int wr, int wc, int fr, int fq) const {
        const int row0 = u.pm * 256 + wr * 64 + fr; const int colt = (u.pn & pnmask) * 256; const int col0 = colt + wc * 32 + 8 * fq;
        f32x4 hb[2][2];
#pragma unroll
        for (int bj = 0; bj < 2; ++bj) { hb[bj][0] = (f32x4){0.f, 0.f, 0.f, 0.f}; hb[bj][1] = hb[bj][0];
            if (HIDM) { const float* bp = bias + u.pn * 256 + wc * 32 + 8 * fq + bj * 128; hb[bj][0] = *(const f32x4*)bp; hb[bj][1] = *(const f32x4*)(bp + 4); } }
        float rscv[2][4];
#pragma unroll
        for (int ai = 0; ai < 2; ++ai)
#pragma unroll
            for (int m = 0; m < 4; ++m) rscv[ai][m] = 1.f;
        if (!HIDM && ssp && u.pm < 64) {
#pragma unroll
            for (int ai = 0; ai < 2; ++ai)
#pragma unroll
                for (int mh = 0; mh < 2; ++mh) { f32x4 t[2][4];
#pragma unroll
                    for (int mm = 0; mm < 2; ++mm)
#pragma unroll
                        for (int i = 0; i < 4; ++i) t[mm][i] = ((const f32x4*)(ssp + (size_t)(row0 + ai * 128 + (mh * 2 + mm) * 16) * 16))[i];
#pragma unroll
                    for (int mm = 0; mm < 2; ++mm) { const f32x4 a = t[mm][0] + t[mm][1] + t[mm][2] + t[mm][3]; rscv[ai][mh * 2 + mm] = rsqrtf((a[0] + a[1] + a[2] + a[3]) * (1.f / 1024.f) + 1e-6f); } } }
#pragma unroll
        for (int ai = 0; ai < 2; ++ai)
#pragma unroll
            for (int m = 0; m < 4; ++m) { bf16_t* rowp = O + (size_t)(row0 + ai * 128 + m * 16) * ldc + col0;
                const float rsc = rscv[ai][m];
#pragma unroll
                for (int bj = 0; bj < 2; ++bj) { f32x4 v0 = acc[ai][bj][m][0] * rsc, v1 = acc[ai][bj][m][1] * rsc;
                    if (HIDM) {
#pragma unroll
                        for (int e = 0; e < 4; ++e) { v0[e] = gelu_t(v0[e] + hb[bj][0][e]); v1[e] = gelu_t(v1[e] + hb[bj][1][e]); } }
                    u32x4 w; w.x = pk2(v0[0], v0[1]); w.y = pk2(v0[2], v0[3]); w.z = pk2(v1[0], v1[1]); w.w = pk2(v1[2], v1[3]);
                    *(u32x4*)(rowp + bj * 128) = w; } }
    }
};
typedef EpiBfT<false> EpiBf; typedef EpiBfT<true> EpiHid;
struct EpiMerge {
    static constexpr bool PERM = false;
    const bf16_t* P; bf16_t* M;
    __device__ __forceinline__ void operator()(const f32x4 (&acc)[2][2][4][2], const Unit& u, int wr, int wc, int fr, int fq) const {
        const int oc = u.pn * 64 + wc * 16 + fq * 4;
        u32x2 pv[2][4][4];
#pragma unroll
        for (int ai = 0; ai < 2; ++ai)
#pragma unroll
            for (int m = 0; m < 4; ++m) { const int row = u.pm * 256 + ai * 128 + wr * 64 + m * 16 + fr;
#pragma unroll
                for (int br = 0; br < 4; ++br) pv[ai][m][br] = *(const u32x2*)(P + ((size_t)br * T_ + row) * 2048 + oc); }
#pragma unroll
        for (int ai = 0; ai < 2; ++ai)
#pragma unroll
            for (int m = 0; m < 4; ++m) { const int row = u.pm * 256 + ai * 128 + wr * 64 + m * 16 + fr;
                float r0 = 0.f, r1 = 0.f, r2 = 0.f, r3 = 0.f;
#pragma unroll
                for (int br = 0; br < 4; ++br) { const u32x2 p = pv[ai][m][br]; const f32x4 a = acc[ai][br >> 1][m][br & 1];
                    r0 += sigm(a[0]) * bf2f((bf16_t)(p.x & 0xffff)); r1 += sigm(a[1]) * bf2f((bf16_t)(p.x >> 16));
                    r2 += sigm(a[2]) * bf2f((bf16_t)(p.y & 0xffff)); r3 += sigm(a[3]) * bf2f((bf16_t)(p.y >> 16)); }
                u32x2 w; w.x = pk2(r0, r1); w.y = pk2(r2, r3); *(u32x2*)(M + (size_t)row * 2048 + oc) = w; }
    }
};
template <bool HASPP> struct EpiResidT {
    static constexpr bool PERM = false;
    float* X; const bf16_t* PP;
    __device__ __forceinline__ void operator()(const f32x4 (&acc)[2][2][4][2], const Unit& u, int wr, int wc, int fr, int fq) const {
        constexpr int NB = HASPP ? 2 : 4;
#pragma unroll
        for (int ai = 0; ai < 2; ++ai)
#pragma unroll
            for (int mh = 0; mh < 4 / NB; ++mh) {
                f32x4 xv[NB][2][2]; u32x2 pp[NB][2][2];
#pragma unroll
                for (int mm = 0; mm < NB; ++mm) { const int row = u.pm * 256 + ai * 128 + wr * 64 + (mh * NB + mm) * 16 + fr;
#pragma unroll
                    for (int bj = 0; bj < 2; ++bj)
#pragma unroll
                        for (int n = 0; n < 2; ++n) { const int col = u.pn * 256 + bj * 128 + wc * 32 + n * 16 + 4 * fq;
                            xv[mm][bj][n] = *(const f32x4*)(X + (size_t)row * 2048 + col); if (HASPP) pp[mm][bj][n] = *(const u32x2*)(PP + (size_t)row * 2048 + col); } }
#pragma unroll
                for (int mm = 0; mm < NB; ++mm) { const int m = mh * NB + mm; const int row = u.pm * 256 + ai * 128 + wr * 64 + m * 16 + fr;
#pragma unroll
                    for (int bj = 0; bj < 2; ++bj)
#pragma unroll
                        for (int n = 0; n < 2; ++n) { const int col = u.pn * 256 + bj * 128 + wc * 32 + n * 16 + 4 * fq; float* xp = X + (size_t)row * 2048 + col;
                            f32x4 x = xv[mm][bj][n]; const f32x4 a = acc[ai][bj][m][n];
                            if (HASPP) { const u32x2 p = pp[mm][bj][n];
                                x[0] += sigm(a[0]) * bf2f((bf16_t)(p.x & 0xffff)); x[1] += sigm(a[1]) * bf2f((bf16_t)(p.x >> 16));
                                x[2] += sigm(a[2]) * bf2f((bf16_t)(p.y & 0xffff)); x[3] += sigm(a[3]) * bf2f((bf16_t)(p.y >> 16)); }
                            else x += a;
                            *(f32x4*)xp = x; } }
            }
    }
};
struct EpiFfn {
    static constexpr bool PERM = true;
    bf16_t* ACT; bf16_t* USIDE; const float* cw; const float* cb;
    __device__ __forceinline__ void operator()(const f32x4 (&acc)[2][2][4][2], const Unit& u, int wr, int wc, int fr, int fq) const {
        const int lane = fq * 16 + fr, src1 = (lane & 48) | ((fr + 15) & 15), src2 = (lane & 48) | ((fr + 14) & 15);
        f32x4 wq[2][8];
#pragma unroll
        for (int n = 0; n < 2; ++n) { const int ch = u.pn * 128 + wc * 32 + 8 * fq + 4 * n;
            wq[n][0] = *(const f32x4*)(cw + ch); wq[n][1] = *(const f32x4*)(cw + 12288 + ch); wq[n][2] = *(const f32x4*)(cw + 24576 + ch); wq[n][3] = *(const f32x4*)(cb + ch);
            wq[n][4] = *(const f32x4*)(cw + 6144 + ch); wq[n][5] = *(const f32x4*)(cw + 12288 + 6144 + ch); wq[n][6] = *(const f32x4*)(cw + 24576 + 6144 + ch); wq[n][7] = *(const f32x4*)(cb + 6144 + ch); }
#pragma unroll
        for (int n = 0; n < 2; ++n) { const int ch = u.pn * 128 + wc * 32 + 8 * fq + 4 * n;
            const f32x4 wg0 = wq[n][0], wg1 = wq[n][1], wg2 = wq[n][2], bg = wq[n][3];
            const f32x4 wv0 = wq[n][4], wv1 = wq[n][5], wv2 = wq[n][6], bv = wq[n][7];
#pragma unroll
            for (int ai = 0; ai < 2; ++ai) { f32x4 g1p = (f32x4){0.f, 0.f, 0.f, 0.f}, g2p = g1p, v1p = g1p, v2p = g1p;
#pragma unroll
                for (int m = 0; m < 4; ++m) { const f32x4 ug = acc[ai][0][m][n], uv = acc[ai][1][m][n]; f32x4 g1, g2, v1, v2;
#pragma unroll
                    for (int e = 0; e < 4; ++e) {
                        g1[e] = __int_as_float(__builtin_amdgcn_update_dpp(0, __float_as_int(ug[e]), 0x121, 0xF, 0xF, false)); g2[e] = __int_as_float(__builtin_amdgcn_update_dpp(0, __float_as_int(ug[e]), 0x122, 0xF, 0xF, false));
                        v1[e] = __int_as_float(__builtin_amdgcn_update_dpp(0, __float_as_int(uv[e]), 0x121, 0xF, 0xF, false)); v2[e] = __int_as_float(__builtin_amdgcn_update_dpp(0, __float_as_int(uv[e]), 0x122, 0xF, 0xF, false)); }
                    const f32x4 pg1 = fr >= 1 ? g1 : g1p, pg2 = fr >= 2 ? g2 : g2p, pv1 = fr >= 1 ? v1 : v1p, pv2 = fr >= 2 ? v2 : v2p;
                    const int row = u.pm * 256 + ai * 128 + wr * 64 + m * 16 + fr;
                    const f32x4 yg = bg + wg0 * pg2 + wg1 * pg1 + wg2 * ug, yv = bv + wv0 * pv2 + wv1 * pv1 + wv2 * uv;
                    if (m > 0 || fr >= 2) { u32x2 w; w.x = pk2(gelu_t(yg[0]) * yv[0], gelu_t(yg[1]) * yv[1]); w.y = pk2(gelu_t(yg[2]) * yv[2], gelu_t(yg[3]) * yv[3]); *(u32x2*)(ACT + (size_t)row * 6144 + ch) = w; }
                    if ((m == 0 && fr < 2) || (m == 3 && fr >= 14)) { bf16_t* sp = USIDE + ((size_t)(row >> 6) * 4 + (m == 0 ? fr : fr - 12)) * 12288 + ch;
                        u32x2 w; w.x = pk2(ug[0], ug[1]); w.y = pk2(ug[2], ug[3]); *(u32x2*)sp = w; w.x = pk2(uv[0], uv[1]); w.y = pk2(uv[2], uv[3]); *(u32x2*)(sp + 6144) = w; }
                    g1p = g1; g2p = g2; v1p = v1; v2p = v2; } } }
    }
};
struct EpiRG {
    static constexpr bool PERM = false;
    const bf16_t* XC; const float* b_r; const float* b_i; const float* spl; bf16_t* LA; bf16_t* UU;
    __device__ __forceinline__ void operator()(const f32x4 (&acc)[2][2][4][2], const Unit& u, int wr, int wc, int fr, int fq) const {
#pragma unroll
        for (int n = 0; n < 2; ++n) { const int ch = u.pn * 128 + wc * 32 + n * 16 + 4 * fq;
            const f32x4 br = *(const f32x4*)(b_r + ch), bi = *(const f32x4*)(b_i + ch), sp = *(const f32x4*)(spl + ch);
            u32x2 xvb[2][4];
#pragma unroll
            for (int ai = 0; ai < 2; ++ai)
#pragma unroll
                for (int m = 0; m < 4; ++m) xvb[ai][m] = *(const u32x2*)(XC + (size_t)(u.pm * 256 + ai * 128 + wr * 64 + m * 16 + fr) * 1024 + ch);
#pragma unroll
            for (int ai = 0; ai < 2; ++ai)
#pragma unroll
                for (int m = 0; m < 4; ++m) { const size_t off = (size_t)(u.pm * 256 + ai * 128 + wr * 64 + m * 16 + fr) * 1024 + ch;
                    const u32x2 xv = xvb[ai][m];
                    const f32x4 ar = acc[ai][0][m][n], aig = acc[ai][1][m][n];
                    const float l0 = sp[0] * sigm(ar[0] + br[0]), l1 = sp[1] * sigm(ar[1] + br[1]), l2 = sp[2] * sigm(ar[2] + br[2]), l3 = sp[3] * sigm(ar[3] + br[3]);
                    u32x2 w; w.x = pk2(l0, l1); w.y = pk2(l2, l3); *(u32x2*)(LA + off) = w;
                    const float u0 = sqrtf(fmaxf(1.f - __expf(2.f * l0), 0.f)) * sigm(aig[0] + bi[0]) * bf2f((bf16_t)(xv.x & 0xffff));
                    const float u1 = sqrtf(fmaxf(1.f - __expf(2.f * l1), 0.f)) * sigm(aig[1] + bi[1]) * bf2f((bf16_t)(xv.x >> 16));
                    const float u2 = sqrtf(fmaxf(1.f - __expf(2.f * l2), 0.f)) * sigm(aig[2] + bi[2]) * bf2f((bf16_t)(xv.y & 0xffff));
                    const float u3 = sqrtf(fmaxf(1.f - __expf(2.f * l3), 0.f)) * sigm(aig[3] + bi[3]) * bf2f((bf16_t)(xv.y >> 16));
                    w.x = pk2(u0, u1); w.y = pk2(u2, u3); *(u32x2*)(UU + off) = w; } }
    }
};

template <class F>
__device__ __forceinline__ void convT(int tidv, int bidv, const F& rowsrc, int K, int ld, bf16_t* dst, int nrows, LAS float* tile) {
    const int tid = tidv, nkt = K >> 6, ntiles = (nrows >> 6) * nkt;
    const int kk0 = tid >> 4, n4 = tid & 15;
    f32x4 v0 = (f32x4){0.f, 0.f, 0.f, 0.f}, v1 = v0;
    int tl = bidv;
    if (tl < ntiles) { const int rt = tl / nkt, kt = tl - rt * nkt; const float* src = rowsrc(rt * 64 + n4 * 4);
        if (src) { v0 = *(const f32x4*)(src + (size_t)(kt * 64 + kk0) * ld); v1 = *(const f32x4*)(src + (size_t)(kt * 64 + kk0 + 32) * ld); } }
    for (; tl < ntiles; tl += gridDim.x) {
        const int rt = tl / nkt, kt = tl - rt * nkt;
        { LAS float* tp = tile + kk0 * 65 + n4 * 4; tp[0] = v0[0]; tp[1] = v0[1]; tp[2] = v0[2]; tp[3] = v0[3];
          tp += 32 * 65; tp[0] = v1[0]; tp[1] = v1[1]; tp[2] = v1[2]; tp[3] = v1[3]; }
        { const int nx = tl + gridDim.x; v0 = (f32x4){0.f, 0.f, 0.f, 0.f}; v1 = v0;
          if (nx < ntiles) { const int rt2 = nx / nkt, kt2 = nx - rt2 * nkt; const float* src = rowsrc(rt2 * 64 + n4 * 4);
              if (src) { v0 = *(const f32x4*)(src + (size_t)(kt2 * 64 + kk0) * ld); v1 = *(const f32x4*)(src + (size_t)(kt2 * 64 + kk0 + 32) * ld); } } }
        __syncthreads();
        { const int jj = tid >> 3, k8 = tid & 7; float f[8];
#pragma unroll
          for (int e = 0; e < 8; ++e) f[e] = tile[(k8 * 8 + e) * 65 + jj];
          *(u32x4*)(dst + (size_t)(rt * 64 + jj) * K + kt * 64 + k8 * 8) = pack8(f); }
        __syncthreads();
    }
}
__device__ __forceinline__ void rms_rows(int tidv, int bidv, const float* Xin, const float* g, bf16_t* H, float* Xc) {
    const int lane = tidv & 63, wv = tidv >> 6;
    for (int row = (bidv * 8 + wv) * 2; row < T_; row += gridDim.x * 16) {
        const float* xr = Xin + (size_t)row * 2048; f32x4 v[2][8]; float ss0 = 0.f, ss1 = 0.f;
#pragma unroll
        for (int i = 0; i < 8; ++i) { v[0][i] = *(const f32x4*)(xr + i * 256 + lane * 4); v[1][i] = *(const f32x4*)(xr + 2048 + i * 256 + lane * 4); }
#pragma unroll
        for (int i = 0; i < 8; ++i) { ss0 += v[0][i][0] * v[0][i][0] + v[0][i][1] * v[0][i][1] + v[0][i][2] * v[0][i][2] + v[0][i][3] * v[0][i][3];
                                      ss1 += v[1][i][0] * v[1][i][0] + v[1][i][1] * v[1][i][1] + v[1][i][2] * v[1][i][2] + v[1][i][3] * v[1][i][3]; }
#pragma unroll
        for (int o = 32; o >= 1; o >>= 1) { ss0 += __shfl_xor(ss0, o); ss1 += __shfl_xor(ss1, o); }
        const float rs[2] = {rsqrtf(ss0 * (1.0f / 2048.0f) + 1e-6f), rsqrtf(ss1 * (1.0f / 2048.0f) + 1e-6f)};
#pragma unroll
        for (int i = 0; i < 8; ++i) { const f32x4 gg = *(const f32x4*)(g + i * 256 + lane * 4);
#pragma unroll
            for (int r = 0; r < 2; ++r) { u32x2 w; w.x = pk2(v[r][i][0] * rs[r] * gg[0], v[r][i][1] * rs[r] * gg[1]); w.y = pk2(v[r][i][2] * rs[r] * gg[2], v[r][i][3] * rs[r] * gg[3]);
                *(u32x2*)(H + (size_t)(row + r) * 2048 + i * 256 + lane * 4) = w; if (Xc) *(f32x4*)(Xc + (size_t)(row + r) * 2048 + i * 256 + lane * 4) = v[r][i]; } }
    }
}

__constant__ double kInvFreqRev[32] = {0.15915494309189535, 0.11934937021124886, 0.08949940160889101, 0.06711508300522726, 0.050329212104487035, 0.03774158471741977, 0.0283021958306234, 0.02122365276477766, 0.015915494309189534, 0.011934937021124886, 0.008949940160889102, 0.006711508300522725, 0.005032921210448704, 0.003774158471741977, 0.00283021958306234, 0.0021223652764777662, 0.0015915494309189536, 0.0011934937021124885, 0.0008949940160889102, 0.0006711508300522726, 0.0005032921210448703, 0.00037741584717419774, 0.00028302195830623395, 0.0002122365276477766, 0.00015915494309189535, 0.00011934937021124886, 8.949940160889102e-05, 6.711508300522725e-05, 5.0329212104487035e-05, 3.774158471741978e-05, 2.8302195830623396e-05, 2.122365276477766e-05};
constexpr float LOG2E = 1.4426950408889634f;
typedef unsigned u32v2 __attribute__((ext_vector_type(2)));
__device__ __forceinline__ float rmax4(float v) {
    u32v2 r = __builtin_amdgcn_permlane16_swap(__float_as_uint(v), __float_as_uint(v), false, false); v = fmaxf(__uint_as_float(r.x), __uint_as_float(r.y));
    r = __builtin_amdgcn_permlane32_swap(__float_as_uint(v), __float_as_uint(v), false, false); return fmaxf(__uint_as_float(r.x), __uint_as_float(r.y)); }
__device__ __forceinline__ float rsum4(float v) {
    u32v2 r = __builtin_amdgcn_permlane16_swap(__float_as_uint(v), __float_as_uint(v), false, false); v = __uint_as_float(r.x) + __uint_as_float(r.y);
    r = __builtin_amdgcn_permlane32_swap(__float_as_uint(v), __float_as_uint(v), false, false); return __uint_as_float(r.x) + __uint_as_float(r.y); }

__device__ __forceinline__ s16x4 tr_read(const LAS bf16_t* p) { return __builtin_amdgcn_ds_read_tr16_b64_v4i16((LAS s16x4*)p); }
__device__ __forceinline__ void stage_rows(int tidv, LAS bf16_t* dst, int ldd, const bf16_t* src, size_t lds_, int nrows, int ncols) {
    const int cpr = ncols >> 3, n = nrows * cpr;
    for (int idx = tidv; idx < n; idx += 512) { const int r = idx / cpr, sg = idx - r * cpr;
        const u32x4 v = *(const u32x4*)(src + (size_t)r * lds_ + sg * 8); *(LAS u32x4*)(dst + r * ldd + sg * 8) = v; }
}
__device__ __forceinline__ void qk_tile(const LAS bf16_t* Ks, const bf16x8 (&qf)[2], f32x4 (&s)[4], int li, int lg) {
#pragma unroll
    for (int kt = 0; kt < 4; ++kt) { s[kt] = (f32x4){0.f, 0.f, 0.f, 0.f};
#pragma unroll
        for (int ks = 0; ks < 2; ++ks) { const bf16x8 kf = *(const LAS bf16x8*)(Ks + (kt * 16 + li) * 72 + ks * 32 + lg * 8); s[kt] = __builtin_amdgcn_mfma_f32_16x16x32_bf16(kf, qf[ks], s[kt], 0, 0, 0); } }
}
template <int DV, int VLD>
__device__ __forceinline__ void pv_tile(const LAS bf16_t* Vs, const f32x4 (&p)[4], f32x4 (&o)[DV / 16], int li, int lg) {
#pragma unroll
    for (int kp = 0; kp < 2; ++kp) {
        bf16x8 pf;
        { const unsigned a0 = pk2(p[2 * kp][0], p[2 * kp][1]), a1 = pk2(p[2 * kp][2], p[2 * kp][3]), a2 = pk2(p[2 * kp + 1][0], p[2 * kp + 1][1]), a3 = pk2(p[2 * kp + 1][2], p[2 * kp + 1][3]);
          pf[0] = (short)(a0 & 0xffff); pf[1] = (short)(a0 >> 16); pf[2] = (short)(a1 & 0xffff); pf[3] = (short)(a1 >> 16); pf[4] = (short)(a2 & 0xffff); pf[5] = (short)(a2 >> 16); pf[6] = (short)(a3 & 0xffff); pf[7] = (short)(a3 >> 16); }
#pragma unroll
        for (int mt = 0; mt < DV / 16; ++mt) {
            const s16x4 v0 = tr_read(Vs + ((2 * kp) * 16 + lg * 4 + (li >> 2)) * VLD + mt * 16 + (li & 3) * 4);
            const s16x4 v1 = tr_read(Vs + ((2 * kp + 1) * 16 + lg * 4 + (li >> 2)) * VLD + mt * 16 + (li & 3) * 4);
            bf16x8 vf; vf[0] = v0[0]; vf[1] = v0[1]; vf[2] = v0[2]; vf[3] = v0[3]; vf[4] = v1[0]; vf[5] = v1[1]; vf[6] = v1[2]; vf[7] = v1[3];
            o[mt] = __builtin_amdgcn_mfma_f32_16x16x32_bf16(vf, pf, o[mt], 0, 0, 0);
        }
    }
}
template <int DV, int VLD, bool MASKED, class MF>
__device__ __forceinline__ void attn_tile(const LAS bf16_t* Ks, const LAS bf16_t* Vs, const bf16x8 (&qf)[2], f32x4 (&o)[DV / 16], float& m, float& l, int li, int lg, const MF& valid) {
    f32x4 s[4]; qk_tile(Ks, qf, s, li, lg);
    float mx = -1e30f;
#pragma unroll
    for (int kt = 0; kt < 4; ++kt)
#pragma unroll
        for (int j = 0; j < 4; ++j) { float sv = s[kt][j] * LOG2E; if (MASKED) sv = valid(kt * 16 + lg * 4 + j) ? sv : -1e30f; s[kt][j] = sv; mx = fmaxf(mx, sv); }
    mx = rmax4(mx);
    if (!__all(mx <= m)) {
        const float mn = fmaxf(m, mx), alpha = __builtin_amdgcn_exp2f(m - mn); m = mn; l *= alpha;
#pragma unroll
        for (int mt = 0; mt < DV / 16; ++mt) o[mt] *= alpha; }
    float ps = 0.f;
#pragma unroll
    for (int kt = 0; kt < 4; ++kt)
#pragma unroll
        for (int j = 0; j < 4; ++j) { float pv = __builtin_amdgcn_exp2f(s[kt][j] - m); if (MASKED) pv = (s[kt][j] > -1e29f) ? pv : 0.f; s[kt][j] = pv; ps += pv; }
    l += ps;
    pv_tile<DV, VLD>(Vs, s, o, li, lg);
}
__device__ __forceinline__ float lsum4(float l) { return rsum4(l); }

struct Ctx { const Params* p; unsigned char* ws; LAS unsigned char* lds; int tid, lane, wv; };

__device__ __forceinline__ int queue_pop(int tidv, LAS unsigned char* lds, unsigned* ctr) {
    LAS int* s_item = (LAS int*)(lds + LDS_MISC);
    __syncthreads();
    if (tidv == 0) *s_item = (int)atomicAdd(ctr, 1u);
    __syncthreads();
    return *s_item;
}

__device__ void phase_w_a(int tidv, int bidv, KP P, int L, LAS unsigned char* lds) {
    unsigned char* ws = P->ws; const int tid = tidv;
    LAS float* tile = (LAS float*)lds;
    if (L == 0) {
        if (bidv == 0 && tid < 64) ((unsigned*)(ws + PS_CTR))[tid] = 0u;
        float2* rope = (float2*)(ws + PS_ROPE);
        for (int idx = bidv * 512 + tid; idx < S_ * 32; idx += gridDim.x * 512) { const int s = idx >> 5, i = idx & 31;
            double rv = (double)s * kInvFreqRev[i]; rv -= (double)(long long)rv; const float rf = (float)rv; rope[idx] = make_float2(__builtin_amdgcn_cosf(rf), __builtin_amdgcn_sinf(rf)); }
    }
    if (L == 0) rms_rows(tidv, bidv, P->in[0], P->in[2], (bf16_t*)(ws + OFF_H), P->X); else rms_rows(tidv, bidv, P->X, P->in[2] + 2048, (bf16_t*)(ws + OFF_H), nullptr);
    if (bidv == gridDim.x - 1) { const int sub = tid >> 8, j = tid & 255; const float* w1 = (sub ? P->in[20] : P->in[18]) + (size_t)L * 2048 * 256; const float* pos = P->in[17] + L * 2048;
        float a = 0.f; for (int k = 0; k < 2048; ++k) a += pos[k] * w1[k * 256 + j]; ((float*)(ws + PS_C1))[tid] = a; }
    if (bidv == gridDim.x - 2) for (int i = tid; i < 1024; i += 512) ((float*)(ws + PS_SPL))[i] = -8.0f * softplus_(-P->in[28][L * 1024 + i]);
    if (bidv == gridDim.x - 3 && tid == 0) { float d1 = 0.f, d2 = 0.f; for (int i = 0; i < 64; ++i) { d1 += P->in[12][L * 64 + i] * P->in[13][L * 64 + i]; d2 += P->in[14][L * 64 + i] * P->in[15][L * 64 + i]; }
        *(float*)(ws + PS_LAM) = __expf(d1) - __expf(d2) + (L == 0 ? 0.2f : 0.35550906759f); }
    { bf16_t* rg = (bf16_t*)(ws + W_RG); const float* wr_ = P->in[24] + (size_t)L * 16 * 4096; const float* wi_ = P->in[26] + (size_t)L * 16 * 4096;
      for (int idx = bidv * 512 + tid; idx < 2048 * 256; idx += gridDim.x * 512) { const int j = idx >> 8, k = idx & 255, pn = j >> 8, c = j & 255, gate = c >> 7, ch = pn * 128 + (c & 127), hb = ch >> 6, o = ch & 63;
          const int ic = 256 * (pn >> 1) + k; float v = 0.f; if ((ic >> 6) == hb) v = (gate ? wi_ : wr_)[(size_t)hb * 4096 + (ic & 63) * 64 + o]; rg[idx] = f2bf(v); } }
    { const float* w = P->in[5] + (size_t)L * 2048 * 10304; convT(tidv, bidv, [=](int j) { return j < 10304 ? w + j : (const float*)nullptr; }, 2048, 10304, (bf16_t*)(ws + W_IN), 10496, tile); }
    { const float* w = P->in[29] + (size_t)L * 4 * 2048 * 2048; convT(tidv, bidv, [=](int j) { const int pn = j >> 8, c = j & 255, bj = c >> 7, wc = (c >> 5) & 3, n = (c >> 4) & 1, fq = (c >> 2) & 3, e = c & 3;
            return w + (size_t)(2 * bj + n) * 2048 * 2048 + (pn * 64 + wc * 16 + fq * 4 + e); }, 2048, 2048, (bf16_t*)(ws + W_G), 8192, tile); }
    { const float* w = P->in[30] + (size_t)L * 4 * 1024 * 2048; convT(tidv, bidv, [=](int j) { return w + (size_t)(j >> 11) * 1024 * 2048 + (j & 2047); }, 1024, 2048, (bf16_t*)(ws + W_B), 8192, tile); }
    { const float* w = P->in[31] + (size_t)L * 2048 * 2048; convT(tidv, bidv, [=](int j) { return w + j; }, 2048, 2048, (bf16_t*)(ws + W_OUT), 2048, tile); }
    { const float* wk = P->in[18] + (size_t)L * 2048 * 256; const float* wv_ = P->in[20] + (size_t)L * 2048 * 256; convT(tidv, bidv, [=](int j) { return j < 256 ? wk + j : wv_ + (j - 256); }, 2048, 256, (bf16_t*)(ws + W_C1), 512, tile); }
}
__device__ void phase_w_b(int tidv, int bidv, KP P, int L, LAS unsigned char* lds) {
    unsigned char* ws = P->ws; LAS float* tile = (LAS float*)lds;
    { const float* w = P->in[32] + (size_t)L * 2048 * 12288; convT(tidv, bidv, [=](int j) { const int pn = j >> 8, c = j & 255; return w + (c < 128 ? 128 * pn + c : 6144 + 128 * pn + (c - 128)); }, 2048, 12288, (bf16_t*)(ws + W_UP), 12288, tile); }
    { const float* w = P->in[35] + (size_t)L * 6144 * 2048; convT(tidv, bidv, [=](int j) { return w + j; }, 6144, 2048, (bf16_t*)(ws + W_DN), 2048, tile); }
    { const float* w = P->in[37] + (size_t)L * 2048 * 2048; convT(tidv, bidv, [=](int j) { return w + j; }, 2048, 2048, (bf16_t*)(ws + W_PG), 2048, tile); }
    { const float* w = P->in[36] + (size_t)L * 256 * 2048; convT(tidv, bidv, [=](int j) { return w + j; }, 256, 2048, (bf16_t*)(ws + W_PP), 2048, tile); }
    { const float* src = P->in[1] + (size_t)L * T_ * 256; bf16_t* dst = (bf16_t*)(ws + W_PB);
      for (size_t i = (size_t)bidv * 512 + tidv; i < (size_t)T_ * 256 / 4; i += (size_t)gridDim.x * 512) { const f32x4 v = *(const f32x4*)(src + i * 4); u32x2 w; w.x = pk2(v[0], v[1]); w.y = pk2(v[2], v[3]); *(u32x2*)(dst + i * 4) = w; } }
}
__device__ void phase_prep(int tidv, int bidv, KP P, int L) {
    unsigned char* ws = P->ws;
    bf16_t* PROJ = (bf16_t*)(ws + OFF_BIG); const float2* rope = (const float2*)(ws + PS_ROPE);
    bf16_t* KC = (bf16_t*)(ws + T_KCVC); bf16_t* VC = KC + (size_t)32 * 2048 * 64;
    bf16_t* XBC = (bf16_t*)(ws + T_XBC); bf16_t* XC = (bf16_t*)(ws + T_XC); float* DT = (float*)(ws + T_DT);
    const float* scw = P->in[6] + L * 4 * 1536; const float* scb = P->in[7] + L * 1536; const float* dtb = P->in[8] + L * 16;
    const float* rcw = P->in[22] + L * 4 * 1024; const float* rcb = P->in[23] + L * 1024;
    for (int i2 = bidv * 512 + tidv; i2 < T_ * 304; i2 += gridDim.x * 512) {
        const int t = i2 / 304, i = (i2 - t * 304) * 2, s = t & 2047, b = t >> 11; bf16_t* prow = PROJ + (size_t)t * LDP;
        if (i < 240) { const int vec = i >> 2, d0 = (i & 3) * 8; int cb; float sc = 1.f;
            if (vec < 16) { cb = B_Q + 64 * vec; sc = 0.125f; } else if (vec < 32) cb = B_K + 64 * (vec - 16); else if (vec < 48) { cb = C_Q + 64 * (vec - 32); sc = 0.125f; }
            else if (vec < 52) cb = C_KS + 64 * (vec - 48); else if (vec < 56) cb = C_KW + 64 * (vec - 52); else cb = C_KC + 64 * (vec - 56);
            const u32x4 a0 = *(const u32x4*)(prow + cb + d0), a1 = *(const u32x4*)(prow + cb + d0 + 8), c0 = *(const u32x4*)(prow + cb + d0 + 32), c1 = *(const u32x4*)(prow + cb + d0 + 40);
            f32x4 cs[8];
#pragma unroll
            for (int e = 0; e < 8; ++e) cs[e] = *(const f32x4*)(rope + s * 32 + d0 + 2 * e);
            float x1[16], x2[16], o1[16], o2[16];
            { float ta[8], tb[8]; unpack8(a0, ta); unpack8(a1, tb);
#pragma unroll
              for (int e = 0; e < 8; ++e) { x1[e] = ta[e]; x1[8 + e] = tb[e]; }
              unpack8(c0, ta); unpack8(c1, tb);
#pragma unroll
              for (int e = 0; e < 8; ++e) { x2[e] = ta[e]; x2[8 + e] = tb[e]; } }
#pragma unroll
            for (int e = 0; e < 16; ++e) { const float cc = cs[e >> 1][(e & 1) * 2], sn = cs[e >> 1][(e & 1) * 2 + 1]; o1[e] = (x1[e] * cc - x2[e] * sn) * sc; o2[e] = (x2[e] * cc + x1[e] * sn) * sc; }
            bf16_t* dst = vec < 56 ? prow + cb : KC + ((size_t)(b * 4 + (vec - 56)) * 2048 + s) * 64;
            { float p[8];
#pragma unroll
              for (int e = 0; e < 8; ++e) p[e] = o1[e];
              *(u32x4*)(dst + d0) = pack8(p);
#pragma unroll
              for (int e = 0; e < 8; ++e) p[e] = o1[8 + e];
              *(u32x4*)(dst + d0 + 8) = pack8(p);
#pragma unroll
              for (int e = 0; e < 8; ++e) p[e] = o2[e];
              *(u32x4*)(dst + d0 + 32) = pack8(p);
#pragma unroll
              for (int e = 0; e < 8; ++e) p[e] = o2[8 + e];
              *(u32x4*)(dst + d0 + 40) = pack8(p); }
        } else if (i < 560) { const bool ssd = i < 432; const int c = ssd ? (i - 240) * 8 : (i - 432) * 8, nch = ssd ? 1536 : 1024, col = (ssd ? A_XBC : D_X) + c;
            const float* cw_ = ssd ? scw : rcw; const float* cb_ = ssd ? scb : rcb;
            u32x4 r[4][2];
#pragma unroll
            for (int k = 0; k < 4; ++k) { const bool ok = s - 3 + k >= 0; const bf16_t* rp = PROJ + (size_t)(t - 3 + k) * LDP + col;
                r[k][0] = ok ? *(const u32x4*)rp : (u32x4){0u, 0u, 0u, 0u}; r[k][1] = ok ? *(const u32x4*)(rp + 8) : (u32x4){0u, 0u, 0u, 0u}; }
            float a[16];
#pragma unroll
            for (int e = 0; e < 16; ++e) a[e] = cb_[c + e];
#pragma unroll
            for (int k = 0; k < 4; ++k) { float x0[8], x1[8]; unpack8(r[k][0], x0); unpack8(r[k][1], x1);
#pragma unroll
                for (int e = 0; e < 8; ++e) { a[e] += cw_[k * nch + c + e] * x0[e]; a[8 + e] += cw_[k * nch + c + 8 + e] * x1[e]; } }
            float p0[8], p1[8];
#pragma unroll
            for (int e = 0; e < 8; ++e) { p0[e] = ssd ? silu_(a[e]) : a[e]; p1[e] = ssd ? silu_(a[8 + e]) : a[8 + e]; }
            bf16_t* dst = (ssd ? XBC + (size_t)t * 1536 : XC + (size_t)t * 1024) + c;
            *(u32x4*)dst = pack8(p0); *(u32x4*)(dst + 8) = pack8(p1);
        } else if (i < 592) { const int q = i - 560, g = q >> 3, d = (q & 7) * 8;
            const u32x4 v0 = *(const u32x4*)(prow + C_VC + q * 8), v1 = *(const u32x4*)(prow + C_VC + q * 8 + 8);
            bf16_t* dst = VC + ((size_t)(b * 4 + g) * 2048 + s) * 64 + d; *(u32x4*)dst = v0; *(u32x4*)(dst + 8) = v1;
        } else { const int hh = i - 592; DT[t * 16 + hh] = softplus_(bf2f(prow[A_DT + hh]) + dtb[hh]); DT[t * 16 + hh + 1] = softplus_(bf2f(prow[A_DT + hh + 1]) + dtb[hh + 1]); }
    }
}

__device__ void item_ssd(int tidv, KP P, int L, LAS unsigned char* lds, int b, int h) {
    unsigned char* ws = P->ws; const int tid = tidv, lane = tid & 63, w = tid >> 6, li = lane & 15, lg = lane >> 4;
    const bf16_t* XBC = (const bf16_t*)(ws + T_XBC); const float* DT = (const float*)(ws + T_DT); bf16_t* O0 = (bf16_t*)(ws + O_O);
    constexpr int CSB = 0, BSB = 17408, XDB = 34816, XWB = 44032, YAB = 53248, YB0B = YAB + 17408, ACSB = YAB + 3 * 17408, DTVB = ACSB + 256;
    LAS bf16_t* Cs = (LAS bf16_t*)(lds + CSB); LAS bf16_t* Bs = (LAS bf16_t*)(lds + BSB); LAS bf16_t* Xd = (LAS bf16_t*)(lds + XDB); LAS bf16_t* Xw = (LAS bf16_t*)(lds + XWB);
    LAS float* yA = (LAS float*)(lds + YAB); LAS float* acs = (LAS float*)(lds + ACSB); LAS float* dtv = (LAS float*)(lds + DTVB);
    const float Aneg = -__expf(P->in[9][L * 16 + h]), Dh = P->in[10][L * 16 + h];
    const bf16_t* PROJ = (const bf16_t*)(ws + OFF_BIG); float* SSP = (float*)(ws + T_SSP);
    const int gi = h >> 3, pt = w & 3, nh = w >> 2, lt = w & 3, pp = w >> 2;
    f32x4 hT[4];
#pragma unroll
    for (int i = 0; i < 4; ++i) hT[i] = (f32x4){0.f, 0.f, 0.f, 0.f};
    const int crow = tid >> 4, cseg = tid & 15, xrow = tid >> 3, xseg = tid & 7;
    float gnr[8];
#pragma unroll
    for (int e = 0; e < 8; ++e) gnr[e] = P->in[11][L * 1024 + h * 64 + xseg * 8 + e];
    const bf16_t* gB = XBC + ((size_t)b * 2048 + crow) * 1536 + 1024 + gi * 128 + cseg * 8;
    const bf16_t* gX = XBC + ((size_t)b * 2048 + xrow) * 1536 + h * 64 + xseg * 8;
    const float* gD = DT + ((size_t)b * 2048 + lane) * 16 + h;
    u32x4 rb0, rb1, rc0, rc1, rx; float rdt = 0.f;
    { rb0 = *(const u32x4*)gB; rb1 = *(const u32x4*)(gB + 32 * 1536); rc0 = *(const u32x4*)(gB + 256); rc1 = *(const u32x4*)(gB + 32 * 1536 + 256); rx = *(const u32x4*)gX; if (w == 0) rdt = *gD; }
    for (int ch = 0; ch < 32; ++ch) {
        __syncthreads();
        { const int o = (crow * 136 + cseg * 8) * 2; *(LAS u32x4*)(lds + BSB + o) = rb0; *(LAS u32x4*)(lds + BSB + o + 32 * 272) = rb1; *(LAS u32x4*)(lds + CSB + o) = rc0; *(LAS u32x4*)(lds + CSB + o + 32 * 272) = rc1; }
        if (w == 0) { float a = rdt * Aneg;
#pragma unroll
            for (int off = 1; off < 64; off <<= 1) { const float t = __shfl_up(a, off); if (lane >= off) a += t; }
            acs[lane] = a; dtv[lane] = rdt; }
        float xr[8]; unpack8(rx, xr);
        __syncthreads();
        if (ch < 31) { const size_t go = (size_t)(ch + 1) * 64 * 1536; rb0 = *(const u32x4*)(gB + go); rb1 = *(const u32x4*)(gB + go + 32 * 1536); rc0 = *(const u32x4*)(gB + go + 256); rc1 = *(const u32x4*)(gB + go + 32 * 1536 + 256);
            rx = *(const u32x4*)(gX + go); if (w == 0) rdt = gD[(size_t)(ch + 1) * 64 * 16]; }
        const u32x4 rz = *(const u32x4*)(PROJ + ((size_t)b * 2048 + ch * 64 + xrow) * LDP + A_Z + h * 64 + xseg * 8);
        { const float d = dtv[xrow], wgt = __expf(acs[63] - acs[xrow]); float xd[8], xw[8];
#pragma unroll
          for (int e = 0; e < 8; ++e) { xd[e] = d * xr[e]; xw[e] = wgt * xd[e]; }
          *(LAS u32x4*)(lds + XDB + (xrow * 72 + xseg * 8) * 2) = pack8(xd); *(LAS u32x4*)(lds + XWB + (xrow * 72 + xseg * 8) * 2) = pack8(xw);
          *(LAS f32x4*)(yA + xrow * 68 + xseg * 8) = (f32x4){Dh * xr[0], Dh * xr[1], Dh * xr[2], Dh * xr[3]}; *(LAS f32x4*)(yA + xrow * 68 + xseg * 8 + 4) = (f32x4){Dh * xr[4], Dh * xr[5], Dh * xr[6], Dh * xr[7]}; }
        __syncthreads();
        { bf16x8 cf[4];
#pragma unroll
          for (int ks = 0; ks < 4; ++ks) cf[ks] = *(const LAS bf16x8*)(Cs + (16 * lt + li) * 136 + ks * 32 + lg * 8);
          const float acl = acs[16 * lt + li];
          f32x4 pw[4];
#pragma unroll
          for (int st = 0; st < 4; ++st) {
              pw[st] = (f32x4){0.f, 0.f, 0.f, 0.f};
              if (st <= lt) { f32x4 g = (f32x4){0.f, 0.f, 0.f, 0.f};
#pragma unroll
                  for (int ks = 0; ks < 4; ++ks) { const bf16x8 bfr = *(const LAS bf16x8*)(Bs + (16 * st + li) * 136 + ks * 32 + lg * 8); g = __builtin_amdgcn_mfma_f32_16x16x32_bf16(bfr, cf[ks], g, 0, 0, 0); }
                  const f32x4 as4 = *(const LAS f32x4*)(acs + 16 * st + 4 * lg);
#pragma unroll
                  for (int j = 0; j < 4; ++j) { float wv = g[j] * __expf(acl - as4[j]); if (st == lt && 4 * lg + j > li) wv = 0.f; pw[st][j] = wv; } }
          }
#pragma unroll
          for (int mt2 = 0; mt2 < 2; ++mt2) { const int mtile = 2 * pp + mt2; f32x4 yT = (f32x4){0.f, 0.f, 0.f, 0.f};
#pragma unroll
              for (int kp = 0; kp < 2; ++kp) if (kp == 0 || lt >= 2) {
                  bf16x8 pf; { const unsigned a0 = pk2(pw[2 * kp][0], pw[2 * kp][1]), a1 = pk2(pw[2 * kp][2], pw[2 * kp][3]), a2 = pk2(pw[2 * kp + 1][0], pw[2 * kp + 1][1]), a3 = pk2(pw[2 * kp + 1][2], pw[2 * kp + 1][3]);
                      pf[0] = (short)(a0 & 0xffff); pf[1] = (short)(a0 >> 16); pf[2] = (short)(a1 & 0xffff); pf[3] = (short)(a1 >> 16); pf[4] = (short)(a2 & 0xffff); pf[5] = (short)(a2 >> 16); pf[6] = (short)(a3 & 0xffff); pf[7] = (short)(a3 >> 16); }
                  const s16x4 v0 = tr_read(Xd + ((2 * kp) * 16 + lg * 4 + (li >> 2)) * 72 + mtile * 16 + (li & 3) * 4);
                  const s16x4 v1 = tr_read(Xd + ((2 * kp + 1) * 16 + lg * 4 + (li >> 2)) * 72 + mtile * 16 + (li & 3) * 4);
                  bf16x8 vf; vf[0] = v0[0]; vf[1] = v0[1]; vf[2] = v0[2]; vf[3] = v0[3]; vf[4] = v1[0]; vf[5] = v1[1]; vf[6] = v1[2]; vf[7] = v1[3];
                  yT = __builtin_amdgcn_mfma_f32_16x16x32_bf16(vf, pf, yT, 0, 0, 0); }
              LAS f32x4* yp = (LAS f32x4*)(yA + (16 * lt + li) * 68 + 16 * mtile + 4 * lg); *yp = *yp + yT; } }
        { LAS float* yB = (LAS float*)(lds + YB0B + nh * 17408);
          bf16x8 hb[2];
#pragma unroll
          for (int k2 = 0; k2 < 2; ++k2) { const unsigned a0 = pk2(hT[2 * k2][0], hT[2 * k2][1]), a1 = pk2(hT[2 * k2][2], hT[2 * k2][3]), a2 = pk2(hT[2 * k2 + 1][0], hT[2 * k2 + 1][1]), a3 = pk2(hT[2 * k2 + 1][2], hT[2 * k2 + 1][3]);
              hb[k2][0] = (short)(a0 & 0xffff); hb[k2][1] = (short)(a0 >> 16); hb[k2][2] = (short)(a1 & 0xffff); hb[k2][3] = (short)(a1 >> 16); hb[k2][4] = (short)(a2 & 0xffff); hb[k2][5] = (short)(a2 >> 16); hb[k2][6] = (short)(a3 & 0xffff); hb[k2][7] = (short)(a3 >> 16); }
#pragma unroll
          for (int l2 = 0; l2 < 4; ++l2) { f32x4 yo = (f32x4){0.f, 0.f, 0.f, 0.f};
#pragma unroll
              for (int k2 = 0; k2 < 2; ++k2) { const u32x2 c0 = *(const LAS u32x2*)(Cs + (16 * l2 + li) * 136 + 16 * (4 * nh + 2 * k2) + 4 * lg), c1 = *(const LAS u32x2*)(Cs + (16 * l2 + li) * 136 + 16 * (4 * nh + 2 * k2 + 1) + 4 * lg);
                  bf16x8 af; af[0] = (short)(c0.x & 0xffff); af[1] = (short)(c0.x >> 16); af[2] = (short)(c0.y & 0xffff); af[3] = (short)(c0.y >> 16); af[4] = (short)(c1.x & 0xffff); af[5] = (short)(c1.x >> 16); af[6] = (short)(c1.y & 0xffff); af[7] = (short)(c1.y >> 16);
                  yo = __builtin_amdgcn_mfma_f32_16x16x32_bf16(af, hb[k2], yo, 0, 0, 0); }
              const f32x4 al = *(const LAS f32x4*)(acs + 16 * l2 + 4 * lg);
#pragma unroll
              for (int j = 0; j < 4; ++j) yB[(16 * l2 + 4 * lg + j) * 68 + 16 * pt + li] = yo[j] * __expf(al[j]); } }
        { const float dec = __expf(acs[63]);
#pragma unroll
          for (int i = 0; i < 4; ++i) hT[i] *= dec;
#pragma unroll
          for (int kp = 0; kp < 2; ++kp) {
              const s16x4 x0 = tr_read(Xw + (32 * kp + 4 * lg + (li >> 2)) * 72 + 16 * pt + (li & 3) * 4), x1 = tr_read(Xw + (32 * kp + 16 + 4 * lg + (li >> 2)) * 72 + 16 * pt + (li & 3) * 4);
              bf16x8 xf; xf[0] = x0[0]; xf[1] = x0[1]; xf[2] = x0[2]; xf[3] = x0[3]; xf[4] = x1[0]; xf[5] = x1[1]; xf[6] = x1[2]; xf[7] = x1[3];
#pragma unroll
              for (int i = 0; i < 4; ++i) { const int ntile = 4 * nh + i;
                  const s16x4 b0 = tr_read(Bs + (32 * kp + 4 * lg + (li >> 2)) * 136 + 16 * ntile + (li & 3) * 4), b1 = tr_read(Bs + (32 * kp + 16 + 4 * lg + (li >> 2)) * 136 + 16 * ntile + (li & 3) * 4);
                  bf16x8 bfr; bfr[0] = b0[0]; bfr[1] = b0[1]; bfr[2] = b0[2]; bfr[3] = b0[3]; bfr[4] = b1[0]; bfr[5] = b1[1]; bfr[6] = b1[2]; bfr[7] = b1[3];
                  hT[i] = __builtin_amdgcn_mfma_f32_16x16x32_bf16(bfr, xf, hT[i], 0, 0, 0); } } }
        __syncthreads();
        { const LAS float* y0 = yA + xrow * 68 + xseg * 8; float v[8], z[8]; const size_t trow = (size_t)b * 2048 + ch * 64 + xrow;
          unpack8(rz, z); float ss = 0.f;
#pragma unroll
          for (int e = 0; e < 8; ++e) { const float t = (y0[e] + y0[4352 + e] + y0[8704 + e]) * silu_(z[e]); ss += t * t; v[e] = t * gnr[e]; }
          ss += __shfl_xor(ss, 1); ss += __shfl_xor(ss, 2); ss += __shfl_xor(ss, 4);
          if (xseg == 0) SSP[trow * 16 + h] = ss;
          *(u32x4*)(O0 + trow * 1024 + h * 64 + xseg * 8) = pack8(v); }
    }
}
__device__ void item_rgscan(int tidv, KP P, LAS unsigned char* lds, int b, int hb) {
    unsigned char* ws = P->ws; const int tid = tidv, cg8 = tid & 7, tc = tid >> 3;
    const bf16_t* LA = (const bf16_t*)(ws + T_LA); const bf16_t* UU = (const bf16_t*)(ws + T_UU); const bf16_t* PROJ = (const bf16_t*)(ws + OFF_BIG); bf16_t* O3 = (bf16_t*)(ws + O_O) + (size_t)3 * T_ * 1024;
    LAS float* sA = (LAS float*)lds; LAS float* sH = sA + 64 * 72;
    const int ch = hb * 64 + cg8 * 8; const size_t r0 = (size_t)b * 2048 + tc * 32;
    float A[8], hh[8];
#pragma unroll
    for (int e = 0; e < 8; ++e) { A[e] = 1.f; hh[e] = 0.f; }
#pragma unroll 4
    for (int t = 0; t < 32; ++t) { float la[8], u[8]; unpack8(*(const u32x4*)(LA + (r0 + t) * 1024 + ch), la); unpack8(*(const u32x4*)(UU + (r0 + t) * 1024 + ch), u);
#pragma unroll
        for (int e = 0; e < 8; ++e) { const float a = __expf(la[e]); hh[e] = a * hh[e] + u[e]; A[e] *= a; } }
#pragma unroll
    for (int e = 0; e < 8; ++e) { sA[tc * 72 + cg8 * 8 + e] = A[e]; sH[tc * 72 + cg8 * 8 + e] = hh[e]; }
    __syncthreads();
    float hc[8];
#pragma unroll
    for (int e = 0; e < 8; ++e) hc[e] = 0.f;
    for (int c = 0; c < tc; ++c) {
#pragma unroll
        for (int e = 0; e < 8; ++e) hc[e] = sA[c * 72 + cg8 * 8 + e] * hc[e] + sH[c * 72 + cg8 * 8 + e]; }
#pragma unroll 4
    for (int t = 0; t < 32; ++t) { float la[8], u[8], gt[8], o[8]; unpack8(*(const u32x4*)(LA + (r0 + t) * 1024 + ch), la); unpack8(*(const u32x4*)(UU + (r0 + t) * 1024 + ch), u);
        unpack8(*(const u32x4*)(PROJ + (r0 + t) * LDP + D_GATE + ch), gt);
#pragma unroll
        for (int e = 0; e < 8; ++e) { const float a = __expf(la[e]); hc[e] = a * hc[e] + u[e]; o[e] = hc[e] * gelu_t(gt[e]); }
        *(u32x4*)(O3 + (r0 + t) * 1024 + ch) = pack8(o); }
}
__device__ void item_cmp2(int tidv, KP P, int L, int it, unsigned* done) {
    unsigned char* ws = P->ws; const int tid = tidv; const bf16_t* HID = (const bf16_t*)(ws + T_HID); bf16_t* dst = (bf16_t*)(ws + T_KC2);
    const int r0 = it * 64, sub = r0 >= 4096; const float* w2 = (sub ? P->in[21] : P->in[19]) + (size_t)L * 256 * 64;
    const int d = tid & 63, rr = tid >> 6; float acc[8];
#pragma unroll
    for (int q = 0; q < 8; ++q) acc[q] = 0.f;
    for (int j0 = 0; j0 < 256; j0 += 8) { float wv[8];
#pragma unroll
        for (int e = 0; e < 8; ++e) wv[e] = w2[(j0 + e) * 64 + d];
#pragma unroll
        for (int q = 0; q < 8; ++q) { float hv[8]; unpack8(*(const u32x4*)(HID + (size_t)(r0 + rr * 8 + q) * 256 + j0), hv);
#pragma unroll
            for (int e = 0; e < 8; ++e) acc[q] += hv[e] * wv[e]; } }
#pragma unroll
    for (int q = 0; q < 8; ++q) dst[(size_t)(r0 + rr * 8 + q) * 64 + d] = f2bf(acc[q]);
    asm volatile("s_waitcnt vmcnt(0)" ::: "memory"); __syncthreads();
    if (tid == 0) { __builtin_amdgcn_fence(__ATOMIC_RELEASE, "agent"); asm volatile("s_waitcnt vmcnt(0)" ::: "memory"); __hip_atomic_fetch_add(done, 1u, __ATOMIC_RELAXED, __HIP_MEMORY_SCOPE_AGENT); }
}
__device__ __forceinline__ bf16x8 pack_p(const f32x4& a, const f32x4& b) { u32x4 w; w.x = pk2(a[0], a[1]); w.y = pk2(a[2], a[3]); w.z = pk2(b[0], b[1]); w.w = pk2(b[2], b[3]); return __builtin_bit_cast(bf16x8, w); }
template <int DV, int VLD, bool MASKED, bool SHAREK, class MF>
__device__ __forceinline__ void attn_tile2(const LAS bf16_t* Ks, const LAS bf16_t* Vs, const bf16x8 (&qf)[2][2], f32x4 (&o)[2][DV / 16], f32x4 (&lacc)[2], float (&m)[2], int li, int lg, const MF& valid) {
    f32x4 s[2][4];
    if (SHAREK) {
#pragma unroll
        for (int kt = 0; kt < 4; ++kt) { s[0][kt] = (f32x4){0.f, 0.f, 0.f, 0.f}; s[1][kt] = (f32x4){0.f, 0.f, 0.f, 0.f};
#pragma unroll
            for (int ks = 0; ks < 2; ++ks) { const bf16x8 k0 = *(const LAS bf16x8*)(Ks + (kt * 16 + li) * 72 + ks * 32 + lg * 8);
                s[0][kt] = __builtin_amdgcn_mfma_f32_16x16x32_bf16(k0, qf[0][ks], s[0][kt], 0, 0, 0); s[1][kt] = __builtin_amdgcn_mfma_f32_16x16x32_bf16(k0, qf[1][ks], s[1][kt], 0, 0, 0); }
            __builtin_amdgcn_sched_barrier(0); } }
    bf16x8 pf[2][2];
#pragma unroll
    for (int g = 0; g < 2; ++g) {
        if (!SHAREK) {
#pragma unroll
            for (int kt = 0; kt < 4; ++kt) { s[g][kt] = (f32x4){0.f, 0.f, 0.f, 0.f};
#pragma unroll
                for (int ks = 0; ks < 2; ++ks) { const bf16x8 kf = *(const LAS bf16x8*)(Ks + g * 64 * 72 + (kt * 16 + li) * 72 + ks * 32 + lg * 8); s[g][kt] = __builtin_amdgcn_mfma_f32_16x16x32_bf16(kf, qf[g][ks], s[g][kt], 0, 0, 0); }
                if (kt & 1) __builtin_amdgcn_sched_barrier(0); } }
        float mx = -1e30f;
#pragma unroll
        for (int kt = 0; kt < 4; ++kt)
#pragma unroll
            for (int j = 0; j < 4; ++j) { float sv = s[g][kt][j]; if (MASKED) { sv = valid(kt * 16 + lg * 4 + j) ? sv : -1e30f; s[g][kt][j] = sv; } mx = fmaxf(mx, sv); }
        mx = rmax4(mx);
        if (!__all(mx <= m[g])) { const float mn = fmaxf(m[g], mx), alpha = __builtin_amdgcn_exp2f((m[g] - mn) * LOG2E); m[g] = mn; lacc[g] *= alpha;
#pragma unroll
            for (int mt = 0; mt < DV / 16; ++mt) o[g][mt] *= alpha; }
        const float nm = -m[g] * LOG2E;
#pragma unroll
        for (int kt = 0; kt < 4; ++kt)
#pragma unroll
            for (int j = 0; j < 4; ++j) { float pv = __builtin_amdgcn_exp2f(fmaf(s[g][kt][j], LOG2E, nm)); if (MASKED) pv = (s[g][kt][j] > -1e29f) ? pv : 0.f; s[g][kt][j] = pv; }
        pf[g][0] = pack_p(s[g][0], s[g][1]); pf[g][1] = pack_p(s[g][2], s[g][3]);
        __builtin_amdgcn_sched_barrier(0);
    }
    bf16x8 ones;
#pragma unroll
    for (int i = 0; i < 8; ++i) ones[i] = (short)0x3F80;
#pragma unroll
    for (int kp = 0; kp < 2; ++kp) {
        lacc[0] = __builtin_amdgcn_mfma_f32_16x16x32_bf16(ones, pf[0][kp], lacc[0], 0, 0, 0); lacc[1] = __builtin_amdgcn_mfma_f32_16x16x32_bf16(ones, pf[1][kp], lacc[1], 0, 0, 0);
#pragma unroll
        for (int mt = 0; mt < DV / 16; ++mt) {
            const s16x4 v0 = tr_read(Vs + ((2 * kp) * 16 + lg * 4 + (li >> 2)) * VLD + mt * 16 + (li & 3) * 4);
            const s16x4 v1 = tr_read(Vs + ((2 * kp + 1) * 16 + lg * 4 + (li >> 2)) * VLD + mt * 16 + (li & 3) * 4);
            bf16x8 vf; vf[0] = v0[0]; vf[1] = v0[1]; vf[2] = v0[2]; vf[3] = v0[3]; vf[4] = v1[0]; vf[5] = v1[1]; vf[6] = v1[2]; vf[7] = v1[3];
            o[0][mt] = __builtin_amdgcn_mfma_f32_16x16x32_bf16(vf, pf[0][kp], o[0][mt], 0, 0, 0); o[1][mt] = __builtin_amdgcn_mfma_f32_16x16x32_bf16(vf, pf[1][kp], o[1][mt], 0, 0, 0);
            if (mt & 1) __builtin_amdgcn_sched_barrier(0);
        }
    }
}
__device__ void item_diff(int tidv, KP P, int L, LAS unsigned char* lds, int b, int h, int qb) {
    unsigned char* ws = P->ws; const int tid = tidv, lane = tid & 63, w = tid >> 6, li = lane & 15, lg = lane >> 4;
    const bf16_t* PROJ = (const bf16_t*)(ws + OFF_BIG); bf16_t* O1 = (bf16_t*)(ws + O_O) + (size_t)1 * T_ * 1024;
    constexpr int BUFB = 35840;
    const int qpos = qb * 128 + w * 16 + li, qmaxw = qb * 128 + w * 16 + 15; const size_t trow = (size_t)b * 2048 + qpos;
    bf16x8 qf[2][2];
#pragma unroll
    for (int g = 0; g < 2; ++g)
#pragma unroll
        for (int ks = 0; ks < 2; ++ks) qf[g][ks] = *(const bf16x8*)(PROJ + trow * LDP + B_Q + h * 128 + g * 64 + ks * 32 + lg * 8);
    f32x4 o[2][8], lacc[2]; float m[2] = {-1e30f, -1e30f};
#pragma unroll
    for (int g = 0; g < 2; ++g) { lacc[g] = (f32x4){0.f, 0.f, 0.f, 0.f};
#pragma unroll
        for (int i = 0; i < 8; ++i) o[g][i] = (f32x4){0.f, 0.f, 0.f, 0.f}; }
    const int krr = (tid >> 3) & 63, ksg = tid & 7, vrr0 = tid >> 4, vsg = tid & 15;
    const bf16_t* gk = PROJ + ((size_t)b * 2048 + krr) * LDP + B_K + h * 128 + ksg * 8;
    const bf16_t* gv = PROJ + ((size_t)b * 2048 + vrr0) * LDP + B_V + h * 128 + vsg * 8;
    const int lk = (krr * 72 + ksg * 8) * 2, lv = 18432 + (vrr0 * 136 + vsg * 8) * 2;
    u32x4 r0, r1, r2, r3;
    { r0 = *(const u32x4*)gk; r1 = *(const u32x4*)(gk + 64); r2 = *(const u32x4*)gv; r3 = *(const u32x4*)(gv + (size_t)32 * LDP); }
    __syncthreads();
    { *(LAS u32x4*)(lds + lk) = r0; *(LAS u32x4*)(lds + 9216 + lk) = r1; *(LAS u32x4*)(lds + lv) = r2; *(LAS u32x4*)(lds + lv + 32 * 272) = r3; }
    __syncthreads();
    const int nkt = 2 * qb + 2;
    for (int kt = 0; kt < nkt; ++kt) {
        const int cur = kt & 1; const bool more = kt + 1 < nkt;
        if (more) { const size_t go = (size_t)(kt + 1) * 64 * LDP; r0 = *(const u32x4*)(gk + go); r1 = *(const u32x4*)(gk + go + 64); r2 = *(const u32x4*)(gv + go); r3 = *(const u32x4*)(gv + go + (size_t)32 * LDP); }
        const LAS bf16_t* Ks = (const LAS bf16_t*)(lds + cur * BUFB); const LAS bf16_t* Vs = (const LAS bf16_t*)(lds + cur * BUFB + 18432);
        const int k0 = kt * 64;
        if (k0 <= qmaxw) {
            if (__all(k0 + 63 <= qpos)) attn_tile2<128, 136, false, false>(Ks, Vs, qf, o, lacc, m, li, lg, [=](int) { return true; });
            else attn_tile2<128, 136, true, false>(Ks, Vs, qf, o, lacc, m, li, lg, [=](int ko) { return k0 + ko <= qpos; }); }
        if (more) { LAS unsigned char* nb = lds + (cur ^ 1) * BUFB; *(LAS u32x4*)(nb + lk) = r0; *(LAS u32x4*)(nb + 9216 + lk) = r1; *(LAS u32x4*)(nb + lv) = r2; *(LAS u32x4*)(nb + lv + 32 * 272) = r3; }
        __syncthreads();
    }
    const float linit = L == 0 ? 0.2f : 0.35550906759f; const float lam = *(const float*)(ws + PS_LAM);
    const float i0 = 1.f / fmaxf(lacc[0][0], 1e-30f), i1 = lam / fmaxf(lacc[1][0], 1e-30f);
    float ss = 0.f;
#pragma unroll
    for (int mt = 0; mt < 8; ++mt) { o[0][mt] = o[0][mt] * i0 - o[1][mt] * i1; ss += o[0][mt][0] * o[0][mt][0] + o[0][mt][1] * o[0][mt][1] + o[0][mt][2] * o[0][mt][2] + o[0][mt][3] * o[0][mt][3]; }
    ss = lsum4(ss); const float rs = rsqrtf(ss * (1.f / 128.f) + 1e-6f) * (1.f - linit);
    const float* gn = P->in[16] + L * 128;
#pragma unroll
    for (int mt = 0; mt < 8; ++mt) { const f32x4 gg = *(const f32x4*)(gn + mt * 16 + lg * 4); u32x2 wv; wv.x = pk2(o[0][mt][0] * rs * gg[0], o[0][mt][1] * rs * gg[1]); wv.y = pk2(o[0][mt][2] * rs * gg[2], o[0][mt][3] * rs * gg[3]);
        *(u32x2*)(O1 + trow * 1024 + h * 128 + mt * 16 + lg * 4) = wv; }
}
template <int MODE>
__device__ __forceinline__ void nsa_branch(int tid, const bf16_t* PROJ, LAS unsigned char* lds, int b, int g, int qpos, const bf16x8 (&qf)[2][2], unsigned selm, unsigned rem, const bf16_t* gptr, u32x2 (&acc)[2][4]) {
    const int lane = tid & 63, li = lane & 15, lg = lane >> 4;
    constexpr int BUFB = 18432;
    f32x4 o[2][4], lacc[2]; float m[2] = {-1e30f, -1e30f};
#pragma unroll
    for (int q = 0; q < 2; ++q) { lacc[q] = (f32x4){0.f, 0.f, 0.f, 0.f};
#pragma unroll
        for (int i = 0; i < 4; ++i) o[q][i] = (f32x4){0.f, 0.f, 0.f, 0.f}; }
    const int rr = tid >> 3, sg = tid & 7;
    const bf16_t* gk = PROJ + ((size_t)b * 2048 + rr) * LDP + (MODE == 0 ? C_KW : C_KS) + g * 64 + sg * 8;
    const bf16_t* gv = PROJ + ((size_t)b * 2048 + rr) * LDP + (MODE == 0 ? C_VW : C_VS) + g * 64 + sg * 8;
    const int lo = (rr * 72 + sg * 8) * 2;
    u32x4 r0, r1;
    int kt = __builtin_ctz(rem); rem &= rem - 1;
    { const size_t go = (size_t)kt * 64 * LDP; r0 = *(const u32x4*)(gk + go); r1 = *(const u32x4*)(gv + go); }
    __syncthreads();
    { *(LAS u32x4*)(lds + lo) = r0; *(LAS u32x4*)(lds + 9216 + lo) = r1; }
    __syncthreads();
    int cur = 0;
    for (;;) {
        const bool more = rem != 0u; int nkt = 0;
        if (more) { nkt = __builtin_ctz(rem); rem &= rem - 1; const size_t go = (size_t)nkt * 64 * LDP; r0 = *(const u32x4*)(gk + go); r1 = *(const u32x4*)(gv + go); }
        const LAS bf16_t* Ks = (const LAS bf16_t*)(lds + cur * BUFB); const LAS bf16_t* Vs = (const LAS bf16_t*)(lds + cur * BUFB + 9216);
        const int k0 = kt * 64;
        if (MODE == 0) {
            if (__all(k0 + 63 <= qpos && k0 > qpos - 512)) attn_tile2<64, 72, false, true>(Ks, Vs, qf, o, lacc, m, li, lg, [=](int) { return true; });
            else if (__any(k0 <= qpos && k0 + 63 > qpos - 512)) attn_tile2<64, 72, true, true>(Ks, Vs, qf, o, lacc, m, li, lg, [=](int ko) { const int kp = k0 + ko; return kp <= qpos && kp > qpos - 512; });
        } else { const bool sel = (selm >> kt) & 1u;
            if (__all(sel && k0 + 63 <= qpos)) attn_tile2<64, 72, false, true>(Ks, Vs, qf, o, lacc, m, li, lg, [=](int) { return true; });
            else if (__any(sel && k0 <= qpos)) attn_tile2<64, 72, true, true>(Ks, Vs, qf, o, lacc, m, li, lg, [=](int ko) { return sel && (k0 + ko <= qpos); }); }
        if (more) { LAS unsigned char* nb = lds + (cur ^ 1) * BUFB; *(LAS u32x4*)(nb + lo) = r0; *(LAS u32x4*)(nb + 9216 + lo) = r1; }
        __syncthreads();
        if (!more) break;
        kt = nkt; cur ^= 1;
    }
#pragma unroll
    for (int q = 0; q < 2; ++q) { const float inv = sigm(bf2f(gptr[q * 3])) / fmaxf(lacc[q][0], 1e-30f);
#pragma unroll
        for (int mt = 0; mt < 4; ++mt) { const f32x4 v = o[q][mt] * inv; const u32x2 pa = acc[q][mt];
            u32x2 w; w.x = pk2(v[0] + bf2f((bf16_t)(pa.x & 0xffff)), v[1] + bf2f((bf16_t)(pa.x >> 16))); w.y = pk2(v[2] + bf2f((bf16_t)(pa.y & 0xffff)), v[3] + bf2f((bf16_t)(pa.y >> 16))); acc[q][mt] = w; } }
}
__device__ void item_nsa(int tidv, KP P, int L, LAS unsigned char* lds, int bg, int pb, unsigned* done) {
    unsigned char* ws = P->ws; const int tid = tidv, lane = tid & 63, w = tid >> 6, li = lane & 15, lg = lane >> 4;
    const bf16_t* PROJ = (const bf16_t*)(ws + OFF_BIG); bf16_t* O2 = (bf16_t*)(ws + O_O) + (size_t)2 * T_ * 1024;
    const bf16_t* KC2 = (const bf16_t*)(ws + T_KC2) + (size_t)bg * 128 * 64; const bf16_t* VC2 = (const bf16_t*)(ws + T_VC2) + (size_t)bg * 128 * 64;
    LAS float* impA = (LAS float*)(lds + 40960); LAS float* impB = impA + 4 * 64 * 33; LAS float* impF = impB + 4 * 64 * 33; LAS unsigned* selb = (LAS unsigned*)(impF + 64 * 33);
    const int b = bg >> 2, g = bg & 3, hp = w >> 2, p0 = pb * 64, pl = (w & 3) * 16 + li, qpos = p0 + pl; const size_t trow = (size_t)b * 2048 + qpos;
    bf16x8 qf[2][2];
#pragma unroll
    for (int q = 0; q < 2; ++q) { const int hd = g * 4 + 2 * hp + q;
#pragma unroll
        for (int ks = 0; ks < 2; ++ks) qf[q][ks] = *(const bf16x8*)(PROJ + trow * LDP + C_Q + hd * 64 + ks * 32 + lg * 8);
 }
    u32x2 acc[2][4];
#pragma unroll
    for (int q = 0; q < 2; ++q)
#pragma unroll
        for (int i = 0; i < 4; ++i) acc[q][i] = (u32x2){0u, 0u};
    const bf16_t* gbase = PROJ + trow * LDP + C_G + (g * 4 + 2 * hp) * 3;
    const int thi = pb;
    { const int tlo = (p0 - 511) > 0 ? ((p0 - 511) >> 6) : 0; const unsigned rem = ((2u << thi) - 1u) & ~((1u << tlo) - 1u);
      nsa_branch<0>(tid, PROJ, lds, b, g, qpos, qf, 0u, rem, gbase + 2, acc); }
    if (tid == 0) { LAS int* cflag = (LAS int*)(lds + LDS_MISC + 96);
        if (*cflag == 0) { while (__hip_atomic_load(done, __ATOMIC_RELAXED, __HIP_MEMORY_SCOPE_AGENT) < 128u) __builtin_amdgcn_s_sleep(8);
            __builtin_amdgcn_fence(__ATOMIC_ACQUIRE, "agent"); asm volatile("s_waitcnt vmcnt(0)" ::: "memory"); *cflag = 1; } }
    __syncthreads();
    { LAS bf16_t* Ks = (LAS bf16_t*)lds; LAS bf16_t* Vs = Ks + 128 * 72;
      stage_rows(tidv, Ks, 72, KC2, 64, 128, 64); stage_rows(tidv, Vs, 72, VC2, 64, 128, 64);
      __syncthreads();
#pragma unroll
      for (int q = 0; q < 2; ++q) {
          f32x4 s0[4], s1[4]; qk_tile(Ks, qf[q], s0, li, lg); __builtin_amdgcn_sched_barrier(0); qk_tile(Ks + 64 * 72, qf[q], s1, li, lg); __builtin_amdgcn_sched_barrier(0);
          float mx = -1e30f;
#pragma unroll
          for (int kt = 0; kt < 4; ++kt)
#pragma unroll
              for (int jj = 0; jj < 4; ++jj) { const int n0 = kt * 16 + lg * 4 + jj, n1 = 64 + n0;
                  const float a = (16 * n0 + 31 <= qpos) ? s0[kt][jj] * LOG2E : -1e30f, c = (16 * n1 + 31 <= qpos) ? s1[kt][jj] * LOG2E : -1e30f; s0[kt][jj] = a; s1[kt][jj] = c; mx = fmaxf(mx, fmaxf(a, c)); }
          mx = rmax4(mx);
          float ps = 0.f;
#pragma unroll
          for (int kt = 0; kt < 4; ++kt)
#pragma unroll
              for (int jj = 0; jj < 4; ++jj) { const float a = s0[kt][jj] > -1e29f ? __builtin_amdgcn_exp2f(s0[kt][jj] - mx) : 0.f, c = s1[kt][jj] > -1e29f ? __builtin_amdgcn_exp2f(s1[kt][jj] - mx) : 0.f; s0[kt][jj] = a; s1[kt][jj] = c; ps += a + c; }
          ps = lsum4(ps); const float inv = 1.f / fmaxf(ps, 1e-30f);
#pragma unroll
          for (int kt = 0; kt < 4; ++kt) { s0[kt] *= inv; s1[kt] *= inv; }
          f32x4 o[4];
#pragma unroll
          for (int i = 0; i < 4; ++i) o[i] = (f32x4){0.f, 0.f, 0.f, 0.f};
          __builtin_amdgcn_sched_barrier(0);
          pv_tile<64, 72>(Vs, s0, o, li, lg); __builtin_amdgcn_sched_barrier(0); pv_tile<64, 72>(Vs + 64 * 72, s1, o, li, lg);
          __builtin_amdgcn_sched_barrier(0);
          { const float gc = sigm(bf2f(gbase[q * 3]));
#pragma unroll
            for (int i = 0; i < 4; ++i) { const f32x4 v = o[i] * gc; const u32x2 pa = acc[q][i];
                u32x2 w; w.x = pk2(v[0] + bf2f((bf16_t)(pa.x & 0xffff)), v[1] + bf2f((bf16_t)(pa.x >> 16))); w.y = pk2(v[2] + bf2f((bf16_t)(pa.y & 0xffff)), v[3] + bf2f((bf16_t)(pa.y >> 16))); acc[q][i] = w; } }
          LAS float* ia = impA + ((2 * hp + q) * 64 + pl) * 33; LAS float* ib = impB + ((2 * hp + q) * 64 + pl) * 33;
#pragma unroll
          for (int kt = 0; kt < 4; ++kt) { const int m0 = kt * 4 + lg, m1 = 16 + m0;
              ia[m0] = s0[kt][0] + s0[kt][1] + s0[kt][2] + 0.5f * s0[kt][3]; ib[m0 + 1] = 0.5f * s0[kt][3];
              ia[m1] = s1[kt][0] + s1[kt][1] + s1[kt][2] + 0.5f * s1[kt][3]; ib[m1 + 1] = 0.5f * s1[kt][3]; }
          if (lg == 0) ib[0] = 0.f;
          __builtin_amdgcn_sched_barrier(0); } }
    __syncthreads();
#pragma unroll
    for (int k = 0; k < 4; ++k) { const int idx = tid + 512 * k, pos = idx >> 5, mm = idx & 31; float v = 0.f;
#pragma unroll
        for (int jj = 0; jj < 4; ++jj) v += impA[(jj * 64 + pos) * 33 + mm] + impB[(jj * 64 + pos) * 33 + mm];
        if (mm == 0 || mm == pb) v = 1e4f; else if (mm > pb) v = -1e30f; impF[pos * 33 + mm] = v; }
    if (tid < 64) selb[tid] = 0u;
    __syncthreads();
    { const int pos = tid >> 3; unsigned bits = 0;
#pragma unroll
      for (int k = 0; k < 4; ++k) { const int mm = (tid & 7) * 4 + k; const float v = impF[pos * 33 + mm]; int cnt = 0;
          for (int m2 = 0; m2 < 32; ++m2) { const float v2 = impF[pos * 33 + m2]; cnt += (v2 > v || (v2 == v && m2 < mm)) ? 1 : 0; }
          if (cnt < 8) bits |= 1u << mm; }
      if (bits) atomicOr((unsigned*)(selb + pos), bits); }
    __syncthreads();
    { const unsigned selm = selb[pl]; unsigned um = 0;
#pragma unroll 8
      for (int i = 0; i < 64; ++i) um |= selb[i];
      nsa_branch<1>(tid, PROJ, lds, b, g, qpos, qf, selm, um & ((2u << thi) - 1u), gbase + 1, acc); }
#pragma unroll
    for (int q = 0; q < 2; ++q) { const int hd = g * 4 + 2 * hp + q;
#pragma unroll
        for (int mt = 0; mt < 4; ++mt) *(u32x2*)(O2 + trow * 1024 + hd * 64 + mt * 16 + lg * 4) = acc[q][mt]; }
}
__device__ void phase_ffn_fix(int tidv, int bidv, KP P, int L) {
    unsigned char* ws = P->ws; const bf16_t* USIDE = (const bf16_t*)(ws + OFF_BIG); bf16_t* ACT = (bf16_t*)(ws + O_ACT);
    const float* cw = P->in[33] + (size_t)L * 3 * 12288; const float* cb = P->in[34] + (size_t)L * 12288;
    for (int it = bidv * 512 + tidv; it < 512 * 768; it += gridDim.x * 512) {
        const int ri = it / 768, c = (it - ri * 768) * 8, r = (ri >> 1) * 64 + (ri & 1), s = r & 2047;
        float ug[8], uv[8];
#pragma unroll
        for (int e = 0; e < 8; ++e) { ug[e] = cb[c + e]; uv[e] = cb[6144 + c + e]; }
#pragma unroll
        for (int k = 0; k < 3; ++k) if (s - 2 + k >= 0) { const int rp = r - 2 + k, m64 = rp & 63, slot = m64 >= 62 ? m64 - 60 : m64;
            const bf16_t* sp = USIDE + ((size_t)(rp >> 6) * 4 + slot) * 12288 + c; float a[8], d[8]; unpack8(*(const u32x4*)sp, a); unpack8(*(const u32x4*)(sp + 6144), d);
#pragma unroll
            for (int e = 0; e < 8; ++e) { ug[e] += cw[k * 12288 + c + e] * a[e]; uv[e] += cw[k * 12288 + 6144 + c + e] * d[e]; } }
        float o[8];
#pragma unroll
        for (int e = 0; e < 8; ++e) o[e] = gelu_t(ug[e]) * uv[e];
        *(u32x4*)(ACT + (size_t)r * 6144 + c) = pack8(o);
    }
}
__device__ void final_norm(int tidv, int bidv, KP P) {
    const int lane = tidv & 63, wv = tidv >> 6; const float* g = P->in[38];
    for (int row = bidv * 8 + wv; row < T_; row += gridDim.x * 8) {
        float* xr = P->X + (size_t)row * 2048; f32x4 v[8]; float ss = 0.f;
#pragma unroll
        for (int i = 0; i < 8; ++i) { v[i] = *(const f32x4*)(xr + i * 256 + lane * 4); ss += v[i][0] * v[i][0] + v[i][1] * v[i][1] + v[i][2] * v[i][2] + v[i][3] * v[i][3]; }
#pragma unroll
        for (int o = 32; o >= 1; o >>= 1) ss += __shfl_xor(ss, o);
        const float rs = rsqrtf(ss * (1.0f / 2048.0f) + 1e-6f);
#pragma unroll
        for (int i = 0; i < 8; ++i) { const f32x4 gg = *(const f32x4*)(g + i * 256 + lane * 4); *(f32x4*)(xr + i * 256 + lane * 4) = v[i] * rs * gg; }
    }
}

#ifdef ONLY_CASE
#define CASE_ON(n) (ONLY_CASE == n)
#else
#define CASE_ON(n) 1
#endif

#define XB_TMO      128
#define XB_XCNT(j)  (256  + 64 * (j))
#define XB_XSUB(j)  (1280 + 64 * (j))
#define XB_XGEN(j)  (2304 + 64 * (j))
#define XB_TOP      3328
#define XB_TOPGEN   3392
#define XCD_BAR_WORDS 3456
#define XB_SPIN_CAP (1u << 20)
__device__ __forceinline__ unsigned xb_ld(unsigned* p)              { return __hip_atomic_load(p, __ATOMIC_RELAXED, __HIP_MEMORY_SCOPE_AGENT); }
__device__ __forceinline__ unsigned xb_add(unsigned* p, unsigned v) { return __hip_atomic_fetch_add(p, v, __ATOMIC_RELAXED, __HIP_MEMORY_SCOPE_AGENT); }
__device__ __forceinline__ unsigned xb_xcc_id() { return (unsigned)__builtin_amdgcn_s_getreg((3 << 11) | 20) & 0xFu; }
#define XB_SPIN(cond, bar) do { unsigned _sp = 0; while (cond) { __builtin_amdgcn_s_sleep(1); \
    if ((++_sp & 255u) == 0u) { if (xb_ld(&(bar)[XB_TMO])) break; if (_sp > XB_SPIN_CAP) { atomicAdd(&(bar)[XB_TMO], 1u); break; } } } } while (0)
__device__ __forceinline__ void xcd_barrier_complete(unsigned* bar, unsigned x, unsigned& nloc, unsigned& nx) {
    const unsigned G = gridDim.x;
    unsigned sum, cnt, mine, sp = 0u;
    for (;;) {
        sum = 0u; cnt = 0u; mine = 0u;
#pragma unroll
        for (unsigned j = 0; j < 16; ++j) { const unsigned c = xb_ld(&bar[XB_XCNT(j)]); sum += c; cnt += (c > 0u) ? 1u : 0u; mine = (j == x) ? c : mine; }
        if (sum == G) break;
        __builtin_amdgcn_s_sleep(1);
        if ((++sp & 255u) == 0u) { if (xb_ld(&bar[XB_TMO])) break; if (sp > XB_SPIN_CAP) { atomicAdd(&bar[XB_TMO], 1u); break; } }
    }
    nloc = mine > 0u ? mine : 1u; nx = cnt > 0u ? cnt : 1u;
}
__device__ __forceinline__ void xcd_barrier(unsigned* bar, volatile LAS unsigned* st) {
    asm volatile("s_waitcnt vmcnt(0)" ::: "memory");
    __syncthreads();
    if (threadIdx.x == 0) {
        const unsigned x = xb_xcc_id();
        __builtin_amdgcn_s_waitcnt(0);
        unsigned nloc = st[0], nx = st[1];
        if (nloc == 0u) { xcd_barrier_complete(bar, x, nloc, nx); st[0] = nloc; st[1] = nx; }
        const unsigned old = xb_add(&bar[XB_XSUB(x)], 1u);
        const unsigned gen = old / nloc;
        if (old + 1u == (gen + 1u) * nloc) {
            __builtin_amdgcn_fence(__ATOMIC_RELEASE, "agent");
            asm volatile("s_waitcnt vmcnt(0)" ::: "memory");
            const unsigned og = xb_add(&bar[XB_TOP], 1u);
            const unsigned tg = og / nx;
            if (og + 1u == (tg + 1u) * nx) xb_add(&bar[XB_TOPGEN], 1u);
            else XB_SPIN(xb_ld(&bar[XB_TOPGEN]) == tg, bar);
            __builtin_amdgcn_fence(__ATOMIC_ACQUIRE, "agent");
            xb_add(&bar[XB_XGEN(x)], 1u);
            asm volatile("s_waitcnt vmcnt(0)" ::: "memory");
        } else {
            XB_SPIN(xb_ld(&bar[XB_XGEN(x)]) == gen, bar);
            __builtin_amdgcn_fence(__ATOMIC_ACQUIRE, "agent");
            asm volatile("s_waitcnt vmcnt(0)" ::: "memory");
        }
    }
    __syncthreads();
}

constexpr int PH_PER_LAYER = 16, N_PHASES = 2 * PH_PER_LAYER + 1;

__device__ void run_phase(int tidv, int bidv, KP P, int ph, LAS unsigned char* lds) {
    unsigned char* ws = P->ws;
    if (ph == 2 * PH_PER_LAYER) { final_norm(tidv, bidv, P); return; }
    const int L = ph / PH_PER_LAYER, k = ph % PH_PER_LAYER; const int G = gridDim.x, c = bidv;
    unsigned* ctr = (unsigned*)(ws + PS_CTR) + L * 4;
    pg8::Order S;
    switch (k) {
#if CASE_ON(0)
    case 0: phase_w_a(tidv, bidv, P, L, lds); break;
#endif
#if CASE_ON(1)
    case 1: { S.init(64, 41, 1, G, c, 0); pg8::gemm_phase<2048, 2048>(tidv, bidv, lds, (const bf16_t*)(ws + OFF_H), (const bf16_t*)(ws + W_IN), S, EpiBf{(bf16_t*)(ws + OFF_BIG), LDP, 0x7fffffff, nullptr, nullptr}); } break;
#endif
#if CASE_ON(2)
    case 2: phase_prep(tidv, bidv, P, L); break;
#endif
#if CASE_ON(3)
    case 3: {
        if (c >= 32) {
            S.init(64, 8, 1, G - 32, c - 32, 1);
            pg8::gemm_phase<1024, 256>(tidv, bidv, lds, (const bf16_t*)(ws + T_XC), (const bf16_t*)(ws + W_RG), S,
                            EpiRG{(const bf16_t*)(ws + T_XC), P->in[25] + L * 1024, P->in[27] + L * 1024, (const float*)(ws + PS_SPL), (bf16_t*)(ws + T_LA), (bf16_t*)(ws + T_UU)});
        } else {
            S.init(16, 1, 2, 32, c, 0);
            pg8::gemm_phase<1024, 2048>(tidv, bidv, lds, (const bf16_t*)(ws + T_KCVC), (const bf16_t*)(ws + W_C1), S, EpiHid{(bf16_t*)(ws + T_HID), 256, 0, (const float*)(ws + PS_C1), nullptr});
        }
    } break;
#endif
#if CASE_ON(4)
    case 4: {
        { LAS int* cflag = (LAS int*)(lds + LDS_MISC + 96); if (tidv == 0) *cflag = 0; }
        int it = queue_pop(tidv, lds, ctr + 0);
        while (it < 384 + 2048) {
            unsigned nxt = 0u; if (tidv == 0) nxt = atomicAdd(ctr + 0, 1u);
#if PROBE_ITEM
            const unsigned long long q0 = wall_clock64();
#endif
            int tv = tidv; asm volatile("" : "+v"(tv)); KP Pq = P; asm volatile("" : "+s"(Pq)); int Lq = L; asm volatile("" : "+s"(Lq));
            int ty;
            if (it < 128) { ty = 3; item_cmp2(tv, Pq, Lq, it, ctr + 3); }
            else if (it < 256) { ty = 1; item_ssd(tv, Pq, Lq, lds, (it - 128) >> 4, (it - 128) & 15); }
            else if (it < 384) { ty = 2; item_rgscan(tv, Pq, lds, (it - 256) >> 4, (it - 256) & 15); }
            else if (it < 384 + 1024) { ty = 4; const int jx = it - 384; item_diff(tv, Pq, Lq, lds, (jx & 63) >> 3, jx & 7, 15 - (jx >> 6)); }
            else { ty = 5; const int jx = it - 384 - 1024; item_nsa(tv, Pq, Lq, lds, jx & 31, 31 - (jx >> 5), ctr + 3); }
#if PROBE_ITEM
            if (ty == PROBE_ITEM) { __syncthreads(); const unsigned long long q1 = wall_clock64(); while (wall_clock64() - q1 < q1 - q0) __builtin_amdgcn_s_sleep(8); }
#endif
            (void)ty;
            { LAS int* s_item = (LAS int*)(lds + LDS_MISC); __syncthreads(); if (tidv == 0) *s_item = (int)nxt; __syncthreads(); it = *s_item; } }
    } break;
#endif
#if CASE_ON(5)
    case 5: break;
#endif
#if CASE_ON(6)
    case 6: break;
#endif
#if CASE_ON(7)
    case 7: { S.init(64, 8, 4, G, c, 0);
        pg8::gemm_phase<1024, 1024>(tidv, bidv, lds, (const bf16_t*)(ws + O_O), (const bf16_t*)(ws + W_B), S, EpiBf{(bf16_t*)(ws + OFF_BIG), 2048, 7, nullptr, (const float*)(ws + T_SSP)});
        phase_w_b(tidv, bidv, P, L, lds); } break;
#endif
#if CASE_ON(8)
    case 8: { S.init(64, 32, 1, G, c, 0); pg8::gemm_phase<2048, 2048>(tidv, bidv, lds, (const bf16_t*)(ws + OFF_H), (const bf16_t*)(ws + W_G), S, EpiMerge{(const bf16_t*)(ws + OFF_BIG), (bf16_t*)(ws + O_MERGED)}); } break;
#endif
#if CASE_ON(9)
    case 9: { S.init(64, 8, 1, G, c, 0); pg8::gemm_phase<2048, 2048>(tidv, bidv, lds, (const bf16_t*)(ws + O_MERGED), (const bf16_t*)(ws + W_OUT), S, EpiResidT<false>{P->X, nullptr}); } break;
#endif
#if CASE_ON(10)
    case 10: rms_rows(tidv, bidv, P->X, P->in[3] + L * 2048, (bf16_t*)(ws + OFF_H), nullptr); break;
#endif
#if CASE_ON(11)
    case 11: { S.init(64, 48, 1, G, c, 0); pg8::gemm_phase<2048, 2048>(tidv, bidv, lds, (const bf16_t*)(ws + OFF_H), (const bf16_t*)(ws + W_UP), S, EpiFfn{(bf16_t*)(ws + O_ACT), (bf16_t*)(ws + OFF_BIG), P->in[33] + (size_t)L * 3 * 12288, P->in[34] + (size_t)L * 12288}); } break;
#endif
#if CASE_ON(12)
    case 12: { phase_ffn_fix(tidv, bidv, P, L);
        asm volatile("" : "+v"(tidv)); asm volatile("" : "+s"(bidv));
        S.init(64, 8, 1, G, c, 0); pg8::gemm_phase<256, 256>(tidv, bidv, lds, (const bf16_t*)(ws + W_PB), (const bf16_t*)(ws + W_PP), S, EpiBf{(bf16_t*)(ws + O_PP), 2048, 0x7fffffff, nullptr, nullptr}); } break;
#endif
#if CASE_ON(13)
    case 13: { S.init(64, 8, 1, G, c, 0); pg8::gemm_phase<6144, 6144>(tidv, bidv, lds, (const bf16_t*)(ws + O_ACT), (const bf16_t*)(ws + W_DN), S, EpiResidT<false>{P->X, nullptr}); } break;
#endif
#if CASE_ON(14)
    case 14: rms_rows(tidv, bidv, P->X, P->in[4] + L * 2048, (bf16_t*)(ws + OFF_H), nullptr); break;
#endif
#if CASE_ON(15)
    case 15: { S.init(64, 8, 1, G, c, 0); pg8::gemm_phase<2048, 2048>(tidv, bidv, lds, (const bf16_t*)(ws + OFF_H), (const bf16_t*)(ws + W_PG), S, EpiResidT<true>{P->X, (const bf16_t*)(ws + O_PP)}); } break;
#endif
    }
}

__global__ void __launch_bounds__(512, 2) hybrid_fwd(Params P, int ph_lo, int ph_hi) {
    extern __shared__ __attribute__((aligned(16))) unsigned char shm[];
    LAS unsigned char* lds = (LAS unsigned char*)shm;
    cg::grid_group grid = cg::this_grid();
    volatile LAS unsigned* xst = (volatile LAS unsigned*)(lds + LDS_MISC + 64);
    unsigned* xbar = (unsigned*)(P.ws + PS_BAR);
    if (threadIdx.x == 0) { xst[0] = 0u; xst[1] = 0u; (void)xb_add(&xbar[XB_XCNT(xb_xcc_id())], 1u); }
    __syncthreads();
    for (int ph = ph_lo; ph < ph_hi; ++ph) {
        { const int kk = ph % PH_PER_LAYER; if (ph < 2 * PH_PER_LAYER && (kk == 5 || kk == 6)) continue; }
        if (ph > ph_lo) { if (ph_lo < 0) grid.sync(); else xcd_barrier(xbar, xst); }
#if PROBE_MASK
        const unsigned long long pt0 = wall_clock64();
#endif
        int tidv = threadIdx.x, bidv = blockIdx.x; asm volatile("" : "+v"(tidv)); asm volatile("" : "+s"(bidv));
        KP kp = (KP)__builtin_amdgcn_kernarg_segment_ptr(); asm volatile("" : "+s"(kp));
        run_phase(tidv, bidv, kp, ph, lds);
        __syncthreads();
#if PROBE_MASK
        if (ph < 2 * PH_PER_LAYER && ((PROBE_MASK >> (ph % PH_PER_LAYER)) & 1)) { const unsigned long long pt1 = wall_clock64(); while (wall_clock64() - pt1 < pt1 - pt0) __builtin_amdgcn_s_sleep(8); }
#endif
    }
}

extern "C" void kernel_launch(void* const* d_in, const int* in_sizes, int n_in, void* d_out, int out_size, void* d_ws, size_t ws_size, hipStream_t stream) {
    static int grid = 0;
    if (grid == 0) {
        int dev = 0, cus = 0, per_cu = 0;
        hipGetDevice(&dev); hipDeviceGetAttribute(&cus, hipDeviceAttributeMultiprocessorCount, dev);
        if (hipFuncSetAttribute((const void*)hybrid_fwd, hipFuncAttributeMaxDynamicSharedMemorySize, LDS_BYTES) != hipSuccess) { fprintf(stderr, "hipFuncSetAttribute failed\n"); grid = -1; return; }
        hipOccupancyMaxActiveBlocksPerMultiprocessor(&per_cu, (const void*)hybrid_fwd, 512, LDS_BYTES);
        if (per_cu < 1) per_cu = 1;
        grid = cus * per_cu; if (grid > 256) grid = 256;
        if (n_in != 39 || ws_size < WS_END) { fprintf(stderr, "kernel_launch: unexpected n_in %d / ws_size %zu (need %zu)\n", n_in, ws_size, (size_t)WS_END); grid = -1; return; }
    }
    if (grid < 0) return;
    if (hipMemsetAsync((char*)d_ws + PS_BAR, 0, XCD_BAR_WORDS * 4, stream) != hipSuccess) { fprintf(stderr, "memset failed\n"); return; }
    Params p{};
    for (int i = 0; i < 39; ++i) p.in[i] = (const float*)d_in[i];
    p.X = (float*)d_out; p.ws = (unsigned char*)d_ws;
#if ONE_LAUNCH
    int lo = 0, hi = N_PHASES;
    void* args[] = {&p, &lo, &hi};
    hipError_t e = hipLaunchCooperativeKernel((const void*)hybrid_fwd, dim3(grid), dim3(512), args, LDS_BYTES, stream);
    if (e != hipSuccess) fprintf(stderr, "cooperative launch failed: %s (grid %d)\n", hipGetErrorString(e), grid);
#else
    for (int ph = 0; ph < N_PHASES; ++ph) hipLaunchKernelGGL(hybrid_fwd, dim3(grid), dim3(512), LDS_BYTES, stream, p, ph, ph + 1);
#endif
}
```
